# Optimizing an MI355X kernel written in HIP

```python
import math
import jax
import jax.numpy as jnp
from jax import lax
import numpy as np


D_MODEL = 2048
BATCH = 4
SEQ = 2048
DEPTH = 1

ML_HEADS = 4
ML_QK_DIM = 128
ML_V_DIM = 256
CONV_WIDTH = 4
CHUNK = 64
MLA_HEADS = 8
MLA_NOPE_DIM = 128
MLA_ROPE_DIM = 64
MLA_V_DIM = 128
Q_LORA_RANK = 512
KV_LORA_RANK = 256
ROPE_THETA = 10000.0
Q_BLOCK = 128
D_FF = 5632
FFN_RES_WEIGHT = 0.5
N_SUBLAYERS = 3
ALPHA = (2.0 * DEPTH) ** 0.25
BETA = (8.0 * DEPTH) ** -0.25
LN_EPS = 1e-5
IN_SIZES = (ML_HEADS * ML_QK_DIM, ML_HEADS * ML_QK_DIM, ML_HEADS * ML_V_DIM, ML_HEADS * ML_V_DIM, ML_HEADS, ML_HEADS, Q_LORA_RANK, KV_LORA_RANK, MLA_ROPE_DIM)
D_IN = sum(IN_SIZES)
MIX_WIDTH = ML_HEADS * ML_V_DIM + MLA_HEADS * MLA_V_DIM

kernel_name = 'hybrid_mlstm_mla_macaron_deepnorm'


def split_last(x, sizes):
    outs = []
    off = 0
    for s in sizes:
        outs.append(x[..., off:off + s])
        off += s
    return outs


def layer_norm(x, g, b):
    xf = x.astype(jnp.float32)
    mu = jnp.mean(xf, axis=-1, keepdims=True)
    var = jnp.mean(jnp.square(xf - mu), axis=-1, keepdims=True)
    return ((xf - mu) * lax.rsqrt(var + LN_EPS) * g + b).astype(x.dtype)


def rms_norm(x, g):
    xf = x.astype(jnp.float32)
    return (xf * lax.rsqrt(jnp.mean(jnp.square(xf), axis=-1, keepdims=True) + LN_EPS) * g).astype(x.dtype)


def modulate(x, shift, scale):
    return x * (1.0 + scale[:, None, :]) + shift[:, None, :]


def swiglu(u, w1, w3, w2):
    return (jax.nn.silu(u @ w1) * (u @ w3)) @ w2


def causal_conv(x, w, b):
    seq = x.shape[1]
    xp = jnp.pad(x, ((0, 0), (CONV_WIDTH - 1, 0), (0, 0)))
    return sum(xp[:, j:j + seq] * w[j] for j in range(CONV_WIDTH)) + b


def rope(x):
    seq = x.shape[1]
    half = x.shape[-1] // 2
    inv = ROPE_THETA ** (-jnp.arange(half, dtype=jnp.float32) / half)
    ang = jnp.arange(seq, dtype=jnp.float32)[:, None] * inv[None, :]
    cos = jnp.cos(ang)[None, :, None, :]
    sin = jnp.sin(ang)[None, :, None, :]
    x1 = x[..., :half].astype(jnp.float32)
    x2 = x[..., half:].astype(jnp.float32)
    return jnp.concatenate([x1 * cos - x2 * sin, x1 * sin + x2 * cos], axis=-1).astype(x.dtype)


def mlstm_chunkwise(q, k, v, i_pre, f_pre):
    bsz, nh, seq, dk = q.shape
    dv = v.shape[-1]
    nc = seq // CHUNK
    qc = q.reshape(bsz, nh, nc, CHUNK, dk)
    kc = k.reshape(bsz, nh, nc, CHUNK, dk)
    vc = v.reshape(bsz, nh, nc, CHUNK, dv)
    logi = i_pre.reshape(bsz, nh, nc, CHUNK)
    bcum = jnp.cumsum(jax.nn.log_sigmoid(f_pre).reshape(bsz, nh, nc, CHUNK), axis=-1)
    g = bcum[..., -1]
    a = g[..., None] - bcum + logi
    m_loc = jnp.max(a, axis=-1)
    wgt = jnp.exp(a - m_loc[..., None])
    c_loc = jnp.einsum('bhcld,bhcle->bhcde', kc * wgt[..., None], vc)
    n_loc = jnp.einsum('bhcl,bhcld->bhcd', wgt, kc)

    def step(carry, inp):
        c_st, n_st, m_st = carry
        g_c, m_l, c_l, n_l = inp
        m_new = jnp.maximum(g_c + m_st, m_l)
        s_old = jnp.exp(g_c + m_st - m_new)
        s_loc = jnp.exp(m_l - m_new)
        c_new = s_old[..., None, None] * c_st + s_loc[..., None, None] * c_l
        n_new = s_old[..., None] * n_st + s_loc[..., None] * n_l
        return (c_new, n_new, m_new), (c_st, n_st, m_st)

    init = (jnp.zeros((bsz, nh, dk, dv), jnp.float32), jnp.zeros((bsz, nh, dk), jnp.float32), jnp.zeros((bsz, nh), jnp.float32))
    xs = (jnp.moveaxis(g, 2, 0), jnp.moveaxis(m_loc, 2, 0), jnp.moveaxis(c_loc, 2, 0), jnp.moveaxis(n_loc, 2, 0))
    _, (c_in, n_in, m_in) = lax.scan(step, init, xs)
    c_in = jnp.moveaxis(c_in, 0, 2)
    n_in = jnp.moveaxis(n_in, 0, 2)
    m_in = jnp.moveaxis(m_in, 0, 2)

    causal = jnp.tril(jnp.ones((CHUNK, CHUNK), dtype=bool))
    log_d = jnp.where(causal, bcum[..., :, None] - bcum[..., None, :] + logi[..., None, :], -jnp.inf)
    log_inter = bcum + m_in[..., None]
    m_t = jnp.maximum(log_inter, jnp.max(log_d, axis=-1))
    s_inter = jnp.exp(log_inter - m_t)
    w_intra = jnp.exp(log_d - m_t[..., None]) * jnp.einsum('bhctd,bhcjd->bhctj', qc, kc)
    num = jnp.einsum('bhctj,bhcje->bhcte', w_intra, vc) + s_inter[..., None] * jnp.einsum('bhctd,bhcde->bhcte', qc, c_in)
    den = jnp.sum(w_intra, axis=-1) + s_inter * jnp.einsum('bhctd,bhcd->bhct', qc, n_in)
    h = num / jnp.maximum(jnp.abs(den), jnp.exp(-m_t))[..., None]
    return h.reshape(bsz, nh, seq, dv)


def blocked_causal_attention(q, k, v):
    bsz, nh, seq, dq = q.shape
    nb = seq // Q_BLOCK
    scale = 1.0 / math.sqrt(dq)
    qb = q.reshape(bsz, nh, nb, Q_BLOCK, dq).transpose(2, 0, 1, 3, 4)
    kpos = jnp.arange(seq)

    def one_block(args):
        q_blk, start = args
        s = jnp.einsum('bhqd,bhkd->bhqk', q_blk, k).astype(jnp.float32) * scale
        qpos = start + jnp.arange(Q_BLOCK)
        s = jnp.where(kpos[None, :] <= qpos[:, None], s, -jnp.inf)
        p = jax.nn.softmax(s, axis=-1).astype(v.dtype)
        return jnp.einsum('bhqk,bhkd->bhqd', p, v)

    o = lax.map(one_block, (qb, jnp.arange(nb) * Q_BLOCK))
    return o.transpose(1, 2, 0, 3, 4).reshape(bsz, nh, seq, v.shape[-1])


def hybrid_mixer(u, w_in, conv_w, conv_b, b_igate, b_fgate, ml_norm_g, q_norm_g, w_uq, kv_norm_g, w_ukv, w_out):
    bsz, seq, _ = u.shape
    f32 = jnp.float32
    ml_q, ml_k, ml_v, ml_o, ml_i, ml_f, c_q, c_kv, k_r = split_last(u @ w_in, IN_SIZES)

    qk = jax.nn.silu(causal_conv(jnp.concatenate([ml_q, ml_k], axis=-1), conv_w, conv_b))
    qk = qk.astype(f32).reshape(bsz, seq, 2, ML_HEADS, ML_QK_DIM).transpose(2, 0, 3, 1, 4)
    q_m = qk[0]
    k_m = qk[1] * (ML_QK_DIM ** -0.5)
    v_m = ml_v.astype(f32).reshape(bsz, seq, ML_HEADS, ML_V_DIM).transpose(0, 2, 1, 3)
    i_pre = (ml_i + b_igate).astype(f32).transpose(0, 2, 1)
    f_pre = (ml_f + b_fgate).astype(f32).transpose(0, 2, 1)
    h = mlstm_chunkwise(q_m, k_m, v_m, i_pre, f_pre)
    mu = jnp.mean(h, axis=-1, keepdims=True)
    var = jnp.mean(jnp.square(h - mu), axis=-1, keepdims=True)
    h = (h - mu) * lax.rsqrt(var + LN_EPS) * ml_norm_g.astype(f32).reshape(ML_HEADS, 1, ML_V_DIM)
    h = h.transpose(0, 2, 1, 3).reshape(bsz, seq, ML_HEADS * ML_V_DIM)
    h_ml = (h * jax.nn.sigmoid(ml_o.astype(f32))).astype(u.dtype)

    q_l = (rms_norm(c_q, q_norm_g) @ w_uq).reshape(bsz, seq, MLA_HEADS, MLA_NOPE_DIM + MLA_ROPE_DIM)
    q_a = jnp.concatenate([q_l[..., :MLA_NOPE_DIM], rope(q_l[..., MLA_NOPE_DIM:])], axis=-1)
    kv = (rms_norm(c_kv, kv_norm_g) @ w_ukv).reshape(bsz, seq, MLA_HEADS, MLA_NOPE_DIM + MLA_V_DIM)
    k_rope = jnp.broadcast_to(rope(k_r[:, :, None, :]), (bsz, seq, MLA_HEADS, MLA_ROPE_DIM))
    k_a = jnp.concatenate([kv[..., :MLA_NOPE_DIM], k_rope], axis=-1)
    v_a = kv[..., MLA_NOPE_DIM:]
    o = blocked_causal_attention(q_a.transpose(0, 2, 1, 3), k_a.transpose(0, 2, 1, 3), v_a.transpose(0, 2, 1, 3))
    h_mla = o.transpose(0, 2, 1, 3).reshape(bsz, seq, MLA_HEADS * MLA_V_DIM)

    return jnp.concatenate([h_ml, h_mla], axis=-1) @ w_out


def setup_inputs(seed: int = 0) -> dict:
    key = jax.random.key(seed)
    ks = jax.random.split(key, 32)
    L = DEPTH
    D = D_MODEL

    def nrm(k, shape, scale):
        return jax.random.normal(k, shape, jnp.float32) * scale

    def gain(k, n):
        return 1.0 + nrm(k, (L, n), 0.01)

    def bias(k, n):
        return nrm(k, (L, n), 0.01)

    return {
        'x': nrm(ks[0], (BATCH, SEQ, D), 1.0),
        'c': nrm(ks[1], (BATCH, D), 1.0),
        'w_ada': nrm(ks[2], (L, D, N_SUBLAYERS * 3 * D), 0.1 * D ** -0.5),
        'b_ada': bias(ks[3], N_SUBLAYERS * 3 * D),
        'ffn1_w1': nrm(ks[4], (L, D, D_FF), D ** -0.5),
        'ffn1_w3': nrm(ks[5], (L, D, D_FF), D ** -0.5),
        'ffn1_w2': nrm(ks[6], (L, D_FF, D), BETA * D_FF ** -0.5),
        'ln1_g': gain(ks[7], D),
        'ln1_b': bias(ks[8], D),
        'w_in': nrm(ks[9], (L, D, D_IN), D ** -0.5),
        'conv_w': nrm(ks[10], (L, CONV_WIDTH, 2 * ML_HEADS * ML_QK_DIM), CONV_WIDTH ** -0.5),
        'conv_b': bias(ks[11], 2 * ML_HEADS * ML_QK_DIM),
        'b_igate': nrm(ks[12], (L, ML_HEADS), 0.1),
        'b_fgate': jnp.linspace(3.0, 6.0, ML_HEADS, dtype=jnp.float32)[None, :] + nrm(ks[13], (L, ML_HEADS), 0.1),
        'ml_norm_g': gain(ks[14], ML_HEADS * ML_V_DIM),
        'q_norm_g': gain(ks[15], Q_LORA_RANK),
        'w_uq': nrm(ks[16], (L, Q_LORA_RANK, MLA_HEADS * (MLA_NOPE_DIM + MLA_ROPE_DIM)), Q_LORA_RANK ** -0.5),
        'kv_norm_g': gain(ks[17], KV_LORA_RANK),
        'w_ukv': nrm(ks[18], (L, KV_LORA_RANK, MLA_HEADS * (MLA_NOPE_DIM + MLA_V_DIM)), KV_LORA_RANK ** -0.5),
        'w_out': nrm(ks[19], (L, MIX_WIDTH, D), BETA * MIX_WIDTH ** -0.5),
        'ln2_g': gain(ks[20], D),
        'ln2_b': bias(ks[21], D),
        'ffn2_w1': nrm(ks[22], (L, D, D_FF), D ** -0.5),
        'ffn2_w3': nrm(ks[23], (L, D, D_FF), D ** -0.5),
        'ffn2_w2': nrm(ks[24], (L, D_FF, D), BETA * D_FF ** -0.5),
        'ln3_g': gain(ks[25], D),
        'ln3_b': bias(ks[26], D),
    }


def reference(x, c, w_ada, b_ada, ffn1_w1, ffn1_w3, ffn1_w2, ln1_g, ln1_b, w_in, conv_w, conv_b, b_igate, b_fgate, ml_norm_g, q_norm_g, w_uq, kv_norm_g, w_ukv, w_out, ln2_g, ln2_b, ffn2_w1, ffn2_w3, ffn2_w2, ln3_g, ln3_b):
    bsz = x.shape[0]
    for l in range(DEPTH):
        mod = (jax.nn.silu(c) @ w_ada[l] + b_ada[l]).reshape(bsz, N_SUBLAYERS, 3, D_MODEL)
        shift, scale, gate = mod[:, :, 0], mod[:, :, 1], mod[:, :, 2]
        y = swiglu(modulate(x, shift[:, 0], scale[:, 0]), ffn1_w1[l], ffn1_w3[l], ffn1_w2[l])
        x = layer_norm(ALPHA * x + FFN_RES_WEIGHT * (1.0 + gate[:, 0])[:, None, :] * y, ln1_g[l], ln1_b[l])
        y = hybrid_mixer(modulate(x, shift[:, 1], scale[:, 1]), w_in[l], conv_w[l], conv_b[l], b_igate[l], b_fgate[l], ml_norm_g[l], q_norm_g[l], w_uq[l], kv_norm_g[l], w_ukv[l], w_out[l])
        x = layer_norm(ALPHA * x + (1.0 + gate[:, 1])[:, None, :] * y, ln2_g[l], ln2_b[l])
        y = swiglu(modulate(x, shift[:, 2], scale[:, 2]), ffn2_w1[l], ffn2_w3[l], ffn2_w2[l])
        x = layer_norm(ALPHA * x + FFN_RES_WEIGHT * (1.0 + gate[:, 2])[:, None, :] * y, ln3_g[l], ln3_b[l])
    return x
```

```cpp
#include <hip/hip_runtime.h>
#include <hip/hip_cooperative_groups.h>
#include <cstdio>
#include <cstdint>
namespace cg = cooperative_groups;

#define LAS __attribute__((address_space(3)))
typedef unsigned short bf16_t;
typedef short bf16x8 __attribute__((ext_vector_type(8)));
typedef short bf16x4 __attribute__((ext_vector_type(4)));
typedef float f32x4 __attribute__((ext_vector_type(4)));
typedef float f32x2 __attribute__((ext_vector_type(2)));
typedef float f32x16 __attribute__((ext_vector_type(16)));
typedef unsigned u32x4 __attribute__((ext_vector_type(4)));
typedef unsigned u32x2 __attribute__((ext_vector_type(2)));

#ifndef DBG_NO_MLSTM
#define DBG_NO_MLSTM 0
#endif
#ifndef DBG_WHICH
#define DBG_WHICH 7
#endif
#ifndef DBG_SELFTEST
#define DBG_SELFTEST 0
#endif
#ifndef DBG_NO_ATTN
#define DBG_NO_ATTN 0
#endif

constexpr int SEQ = 2048, NB = 4, M = NB * SEQ, D = 2048, FF = 5632, NIN = 4096, DIN = 3912, NMOD = 18432;
constexpr float ALPHA = 1.189207115002721f;
constexpr float LN_EPS = 1e-5f;
constexpr float QSCALE = 0.07216878364870322f * 1.4426950408889634f;
constexpr int COL_CQ = 3080, COL_CKV = 3592, COL_KR = 3848;

constexpr size_t MiB = 1u << 20;
constexpr size_t WS_MOD = 1 * MiB, WS_ROPE = 2 * MiB, WS_GATES = 3 * MiB;
constexpr size_t WS_W13A = 4 * MiB, WS_W2A = 48 * MiB, WS_W13B = 70 * MiB, WS_W2B = 114 * MiB;
constexpr size_t WS_WIN = 136 * MiB, WS_WUQ = 152 * MiB, WS_WK = 154 * MiB, WS_WV = WS_WK + 524288, WS_WOUT = 156 * MiB;
constexpr size_t WS_U = 164 * MiB, WS_Z = 196 * MiB, WS_X = 260 * MiB, WS_R = 324 * MiB;
constexpr size_t WS_H = WS_R;
constexpr size_t WS_P = WS_R, WS_QA = WS_R + 64 * MiB, WS_KN = WS_R + 88 * MiB, WS_VT = WS_R + 104 * MiB, WS_HM = WS_R + 120 * MiB, WS_HRAW = WS_R + 152 * MiB;
constexpr size_t WS_QC = WS_R + 184 * MiB, WS_KC = WS_R + 192 * MiB, WS_VTM = WS_R + 200 * MiB, WS_EG = WS_R + 216 * MiB, WS_MG = WS_EG + 131072;
constexpr size_t WS_END = WS_R + 217 * MiB;

constexpr int LDS_BYTES = 147456;
constexpr int TAB_OFF = 131072 + 1024;

__device__ __forceinline__ unsigned cvt_pk_bf16(float lo, float hi) { unsigned r; asm volatile("v_cvt_pk_bf16_f32 %0, %1, %2" : "=v"(r) : "v"(lo), "v"(hi)); return r; }
__device__ __forceinline__ float bf2f(unsigned short b) { return __builtin_bit_cast(float, (unsigned)b << 16); }
__device__ __forceinline__ float bflo(unsigned w) { return __builtin_bit_cast(float, w << 16); }
__device__ __forceinline__ float bfhi(unsigned w) { return __builtin_bit_cast(float, w & 0xffff0000u); }
__device__ __forceinline__ float wave_sum(float v) {
#pragma unroll
    for (int o = 1; o < 64; o <<= 1) v += __shfl_xor(v, o);
    return v;
}
__device__ __forceinline__ float silu_f(float a) { return a * __builtin_amdgcn_rcpf(1.f + __expf(-a)); }
#define LDS_WAIT() asm volatile("s_waitcnt lgkmcnt(0)" ::: "memory")
__device__ __forceinline__ int opaque_tid() { int t = threadIdx.x; asm volatile("" : "+v"(t)); return t; }

namespace pg8 {
constexpr int BM = 256, BK = 64, HALF = 128, HTB = HALF * BK * 2, STAGE_BYTES = 8 * HTB, NXCD = 8, WGM = 8;
__host__ __device__ __forceinline__ int lds_byte(int r, int c) { const int st = (r >> 4) * 2 + (c >> 5), rr = r & 15, cc = c & 31, ob = rr * 64 + cc * 2; return st * 1024 + (ob ^ (((ob >> 9) & 1) << 5)); }
__host__ __device__ __forceinline__ void stage_rc(int b, int& R, int& C) { const int st = b / 1024, sb = b % 1024, swz = sb ^ (((sb >> 9) & 1) << 5); R = (st >> 1) * 16 + swz / 64; C = (st & 1) * 32 + (swz % 64) / 2; }
__host__ __device__ __forceinline__ int perm32(int rho) { const int n = rho >> 4, i = rho & 15; return 8 * (i >> 2) + 4 * n + (i & 3); }

struct Unit { int pm, pn; };
struct Gemm { const bf16_t* A; const bf16_t* Bt; int lda, ldb, K; };

struct StaticOrder {
    int nM, nN, nwg, G, c;
    __device__ void init(int Mr, int Nc, int G_, int c_) { nM = Mr / BM; nN = Nc / BM; nwg = nM * nN; G = G_; c = c_; }
    __device__ bool next(int i, Unit& u) const {
        const long L = (long)i * G + c; if (L >= nwg) return false;
        int wgid = (int)L; { const int q = nwg / NXCD, r = nwg % NXCD, xcd = wgid % NXCD, off = wgid / NXCD; wgid = (xcd < r ? xcd * (q + 1) : r * (q + 1) + (xcd - r) * q) + off; }
        const int nig = WGM * nN, gid = wgid / nig, fm = gid * WGM, gsz = (nM - fm) < WGM ? (nM - fm) : WGM;
        u.pm = fm + ((wgid % nig) % gsz); u.pn = (wgid % nig) / gsz; return true;
    }
};
struct SingleUnit { Unit u0; __device__ bool next(int i, Unit& u) const { if (i != 0) return false; u = u0; return true; } };

template <class Epi, class Sched, bool ALIGN_EPI>
__device__ __forceinline__ void gemm_phase(LAS unsigned char* lds, const Gemm g, const Sched& S, const Epi& E) {
    const int tid = opaque_tid(), wid = __builtin_amdgcn_readfirstlane(tid >> 6), lane = tid & 63, wr = wid >> 2, wc = wid & 3, fr = lane & 15, fq = lane >> 4;
    const int K = g.K, nt = K / BK;
    unsigned voffA[2], voffB[2];
#pragma unroll
    for (int i = 0; i < 2; ++i) { int R, C; stage_rc(tid * 16 + i * 8192, R, C); const int Rb = Epi::PERM ? ((R & ~31) + perm32(R & 31)) : R;
        voffA[i] = (unsigned)(R * g.lda + C) * 2u; voffB[i] = (unsigned)(Rb * g.ldb + C) * 2u; }
    const size_t kstep = (size_t)(BK * 2);
    const size_t hstepA = (size_t)HALF * g.lda * 2, hstepB = (size_t)HALF * g.ldb * 2;
    const size_t tstepA = 2 * hstepA, tstepB = 2 * hstepB;
    const unsigned ldsw = (unsigned)wid * 1024u;
    const int aoff = lds_byte(wr * 64 + fr, fq * 8), boff = lds_byte(wc * 32 + fr, fq * 8);
#define PG8_SA(b, h) (((b) * 2 + (h)) * HTB)
#define PG8_SB(b, h) ((4 + (b) * 2 + (h)) * HTB)
#define PG8_STAGE(bufoff, gbase, voff) do { _Pragma("unroll") for (int _i = 0; _i < 2; ++_i) \
        __builtin_amdgcn_global_load_lds((const unsigned*)((const char*)(gbase) + (voff)[_i]), (LAS unsigned*)(lds + (bufoff) + ldsw + _i * 8192), 16, 0, 0); } while (0)
#define PG8_LDA(dst, b, h) do { _Pragma("unroll") for (int m = 0; m < 4; ++m) _Pragma("unroll") for (int k = 0; k < 2; ++k) dst[m][k] = *(const LAS bf16x8*)(lds + PG8_SA(b, h) + aoff + m * 2048 + k * 1024); } while (0)
#define PG8_LDB(dst, b, h) do { _Pragma("unroll") for (int n = 0; n < 2; ++n) _Pragma("unroll") for (int k = 0; k < 2; ++k) dst[n][k] = *(const LAS bf16x8*)(lds + PG8_SB(b, h) + boff + n * 2048 + k * 1024); } while (0)
#define PG8_MMA(ai, bj, At, Bt) do { __builtin_amdgcn_s_setprio(1); _Pragma("unroll") for (int m = 0; m < 4; ++m) _Pragma("unroll") for (int n = 0; n < 2; ++n) _Pragma("unroll") for (int k = 0; k < 2; ++k) \
        acc[ai][bj][m][n] = __builtin_amdgcn_mfma_f32_16x16x32_bf16(Bt[n][k], At[m][k], acc[ai][bj][m][n], 0, 0, 0); __builtin_amdgcn_s_setprio(0); } while (0)
#define PG8_WAIT_V(n) asm volatile("s_waitcnt vmcnt(" #n ")" ::: "memory")
#define PG8_WAIT_L(n) asm volatile("s_waitcnt lgkmcnt(" #n ")" ::: "memory")
#define PG8_BAR __builtin_amdgcn_s_barrier()
#define PG8_SCHED __builtin_amdgcn_sched_barrier(0)
    Unit cur, nxt; int ui = 0;
    if (!S.next(0, cur)) return;
    f32x4 acc[2][2][4][2];
#pragma unroll
    for (int a = 0; a < 2; ++a)
#pragma unroll
        for (int b = 0; b < 2; ++b)
#pragma unroll
            for (int m = 0; m < 4; ++m)
#pragma unroll
                for (int n = 0; n < 2; ++n) acc[a][b][m][n] = (f32x4){0.f, 0.f, 0.f, 0.f};
    bf16x8 At[4][2], B0[2][2], B1[2][2];
    const char* cA = (const char*)g.A + (size_t)cur.pm * tstepA; const char* cB = (const char*)g.Bt + (size_t)cur.pn * tstepB;
    PG8_STAGE(PG8_SB(0, 0), cB, voffB); PG8_STAGE(PG8_SB(0, 1), cB + hstepB, voffB); PG8_STAGE(PG8_SA(0, 0), cA, voffA); PG8_STAGE(PG8_SA(0, 1), cA + hstepA, voffA);
    if (wr == 1) PG8_BAR;
    PG8_WAIT_V(2); PG8_BAR;
    PG8_STAGE(PG8_SB(1, 0), cB + kstep, voffB); PG8_STAGE(PG8_SA(1, 0), cA + kstep, voffA); PG8_STAGE(PG8_SB(1, 1), cB + hstepB + kstep, voffB);
    PG8_WAIT_V(6); PG8_BAR;
    for (;;) {
        const bool has_next = S.next(ui + 1, nxt);
        const char* nA = has_next ? (const char*)g.A + (size_t)nxt.pm * tstepA : cA; const char* nB = has_next ? (const char*)g.Bt + (size_t)nxt.pn * tstepB : cB;
        for (int t = 0; t < nt; t += 2) {
            const bool last = (t == nt - 2);
            const char* a1 = cA + (size_t)(t + 1) * kstep;
            const char* a2 = last ? nA : cA + (size_t)(t + 2) * kstep; const char* b2 = last ? nB : cB + (size_t)(t + 2) * kstep;
            const char* a3 = a2 + kstep; const char* b3 = b2 + kstep;
            PG8_LDB(B0, 0, 0); PG8_LDB(B1, 0, 1); PG8_SCHED; PG8_LDA(At, 0, 0); PG8_STAGE(PG8_SA(1, 1), a1 + hstepA, voffA);
            PG8_WAIT_V(8); PG8_WAIT_L(0); PG8_BAR; PG8_MMA(0, 0, At, B0); PG8_MMA(0, 1, At, B1); PG8_BAR; PG8_SCHED;
            PG8_LDA(At, 0, 1); PG8_STAGE(PG8_SB(0, 0), b2, voffB); PG8_STAGE(PG8_SB(0, 1), b2 + hstepB, voffB); PG8_STAGE(PG8_SA(0, 0), a2, voffA);
            PG8_WAIT_V(8); PG8_WAIT_L(0); PG8_BAR; PG8_MMA(1, 0, At, B0); PG8_MMA(1, 1, At, B1); PG8_BAR; PG8_SCHED;
            PG8_LDB(B0, 1, 0); PG8_LDB(B1, 1, 1); PG8_SCHED; PG8_LDA(At, 1, 0); PG8_STAGE(PG8_SA(0, 1), a2 + hstepA, voffA);
            PG8_WAIT_V(8); PG8_WAIT_L(0); PG8_BAR; PG8_MMA(0, 0, At, B0); PG8_MMA(0, 1, At, B1); PG8_BAR; PG8_SCHED;
            PG8_LDA(At, 1, 1); PG8_STAGE(PG8_SB(1, 0), b3, voffB); PG8_STAGE(PG8_SB(1, 1), b3 + hstepB, voffB); PG8_STAGE(PG8_SA(1, 0), a3, voffA);
            PG8_WAIT_V(8); PG8_WAIT_L(0); PG8_BAR; PG8_MMA(1, 0, At, B0); PG8_MMA(1, 1, At, B1); PG8_BAR; PG8_SCHED;
        }
        if constexpr (ALIGN_EPI) { if (wr == 0) PG8_BAR; }
        E(acc, cur, wr, wc, fr, fq);
        if (!has_next) break;
#pragma unroll
        for (int a = 0; a < 2; ++a)
#pragma unroll
            for (int b = 0; b < 2; ++b)
#pragma unroll
                for (int m = 0; m < 4; ++m)
#pragma unroll
                    for (int n = 0; n < 2; ++n) acc[a][b][m][n] = (f32x4){0.f, 0.f, 0.f, 0.f};
        cur = nxt; cA = nA; cB = nB; ++ui;
        if constexpr (ALIGN_EPI) { if (wr == 1) PG8_BAR; }
    }
    PG8_WAIT_V(0);
    if constexpr (!ALIGN_EPI) { if (wr == 0) PG8_BAR; }
    PG8_BAR;
#undef PG8_SA
#undef PG8_SB
#undef PG8_STAGE
#undef PG8_LDA
#undef PG8_LDB
#undef PG8_MMA
#undef PG8_WAIT_V
#undef PG8_WAIT_L
#undef PG8_BAR
#undef PG8_SCHED
}

typedef f32x4 Acc[2][2][4][2];

struct EpiSwiglu {
    static constexpr bool PERM = true;
    bf16_t* H;
    __device__ __forceinline__ void operator()(const Acc& acc, const Unit& u, int wr, int wc, int fr, int fq) const {
        const int row0 = u.pm * BM + wr * 64 + fr, col0 = u.pn * 128 + wc * 32 + 8 * fq;
#pragma unroll
        for (int ai = 0; ai < 2; ++ai)
#pragma unroll
            for (int m = 0; m < 4; ++m) {
                const f32x4 a0 = acc[ai][0][m][0], a1 = acc[ai][0][m][1], b0 = acc[ai][1][m][0], b1 = acc[ai][1][m][1];
                u32x4 w;
                w.x = cvt_pk_bf16(silu_f(a0[0]) * b0[0], silu_f(a0[1]) * b0[1]); w.y = cvt_pk_bf16(silu_f(a0[2]) * b0[2], silu_f(a0[3]) * b0[3]);
                w.z = cvt_pk_bf16(silu_f(a1[0]) * b1[0], silu_f(a1[1]) * b1[1]); w.w = cvt_pk_bf16(silu_f(a1[2]) * b1[2], silu_f(a1[3]) * b1[3]);
                *(u32x4*)(H + (size_t)(row0 + ai * HALF + m * 16) * FF + col0) = w;
            }
    }
};
struct EpiResid {
    static constexpr bool PERM = false;
    const float* X; float* Z; const float* gate; float coef;
    __device__ __forceinline__ void operator()(const Acc& acc, const Unit& u, int wr, int wc, int fr, int fq) const {
        const int row0 = u.pm * BM + wr * 64 + fr, b = u.pm >> 3, colb = u.pn * BM + wc * 32 + 4 * fq;
#pragma unroll
        for (int bj = 0; bj < 2; ++bj)
#pragma unroll
            for (int n = 0; n < 2; ++n) {
                const int col = colb + bj * HALF + n * 16;
                f32x4 gv = *(const f32x4*)(gate + (size_t)b * NMOD + col); gv = (gv + 1.0f) * coef;
#pragma unroll
                for (int ai = 0; ai < 2; ++ai)
#pragma unroll
                    for (int m = 0; m < 4; ++m) {
                        const size_t off = (size_t)(row0 + ai * HALF + m * 16) * D + col;
                        const f32x4 x = *(const f32x4*)(X + off);
                        *(f32x4*)(Z + off) = x * ALPHA + gv * acc[ai][bj][m][n];
                    }
            }
    }
};
__device__ __forceinline__ void rope8(f32x4& v0, f32x4& v1, const f32x2* cs) {
    const f32x2 c0 = cs[0], c1 = cs[1], c2 = cs[2], c3 = cs[3];
    float a, b;
    a = v0[0]; b = v0[1]; v0[0] = a * c0.x - b * c0.y; v0[1] = a * c0.y + b * c0.x;
    a = v0[2]; b = v0[3]; v0[2] = a * c1.x - b * c1.y; v0[3] = a * c1.y + b * c1.x;
    a = v1[0]; b = v1[1]; v1[0] = a * c2.x - b * c2.y; v1[1] = a * c2.y + b * c2.x;
    a = v1[2]; b = v1[3]; v1[2] = a * c3.x - b * c3.y; v1[3] = a * c3.y + b * c3.x;
}
struct EpiWin {
    static constexpr bool PERM = true;
    bf16_t* P; float* GATES; const f32x2* ROPE;
    __device__ __forceinline__ void operator()(const Acc& acc, const Unit& u, int wr, int wc, int fr, int fq) const {
        const int row0 = u.pm * BM + wr * 64 + fr, colb = u.pn * BM + wc * 32 + 8 * fq;
#pragma unroll
        for (int bj = 0; bj < 2; ++bj) {
            const int col = colb + bj * HALF;
            const bool isg = (col == 3072), isr = (col >= COL_KR && col < COL_KR + 64);
#pragma unroll
            for (int ai = 0; ai < 2; ++ai)
#pragma unroll
                for (int m = 0; m < 4; ++m) {
                    const int row = row0 + ai * HALF + m * 16;
                    f32x4 v0 = acc[ai][bj][m][0], v1 = acc[ai][bj][m][1];
                    if (isg) { *(f32x4*)(GATES + (size_t)row * 8) = v0; *(f32x4*)(GATES + (size_t)row * 8 + 4) = v1; }
                    if (isr) rope8(v0, v1, ROPE + (size_t)(row & (SEQ - 1)) * 32 + ((col - COL_KR) >> 1));
                    u32x4 w; w.x = cvt_pk_bf16(v0[0], v0[1]); w.y = cvt_pk_bf16(v0[2], v0[3]); w.z = cvt_pk_bf16(v1[0], v1[1]); w.w = cvt_pk_bf16(v1[2], v1[3]);
                    *(u32x4*)(P + (size_t)row * NIN + col) = w;
                }
        }
    }
};
struct EpiLR {
    static constexpr bool PERM = true;
    int mode; bf16_t* O; int ldo; const LAS float* tab; const f32x2* ROPE;
    __device__ __forceinline__ void operator()(const Acc& acc, const Unit& u, int wr, int wc, int fr, int fq) const {
#pragma unroll
        for (int bj = 0; bj < 2; ++bj) {
            const int lcol = wc * 32 + 8 * fq + bj * HALF, col = u.pn * BM + lcol;
            f32x4 c0 = {1.f, 1.f, 1.f, 1.f}, c1 = c0;
            if (mode == 2) { c0 = *(const LAS f32x4*)(tab + lcol); c1 = *(const LAS f32x4*)(tab + lcol + 4); }
            const int within = col % 192;
            const bool isr = (mode == 0) && (within >= 128);
#pragma unroll
            for (int ai = 0; ai < 2; ++ai)
#pragma unroll
                for (int m = 0; m < 4; ++m) {
                    const int lrow = wr * 64 + fr + ai * HALF + m * 16, row = u.pm * BM + lrow;
                    f32x4 v0 = acc[ai][bj][m][0] * c0, v1 = acc[ai][bj][m][1] * c1;
                    if (mode != 2) { float r = tab[lrow]; if (mode == 0) r *= QSCALE; v0 = v0 * r; v1 = v1 * r; }
                    if (isr) rope8(v0, v1, ROPE + (size_t)(row & (SEQ - 1)) * 32 + ((within - 128) >> 1));
                    u32x4 w; w.x = cvt_pk_bf16(v0[0], v0[1]); w.y = cvt_pk_bf16(v0[2], v0[3]); w.z = cvt_pk_bf16(v1[0], v1[1]); w.w = cvt_pk_bf16(v1[2], v1[3]);
                    *(u32x4*)(O + (size_t)row * ldo + col) = w;
                }
        }
    }
};
}

__device__ __forceinline__ int map_row(int kind, int n) {
    switch (kind) {
        case 0: return (n >> 7) * 256 + (n & 127);
        case 1: return (n >> 7) * 256 + 128 + (n & 127);
        case 3: { if (n < COL_KR) return n; const int j = n - COL_KR; return COL_KR + ((j < 32) ? 2 * j : 2 * (j - 32) + 1); }
        case 4: { const int h = n / 192, r = n - h * 192; if (r < 128) return n; const int j = r - 128; return h * 192 + 128 + ((j < 32) ? 2 * j : 2 * (j - 32) + 1); }
        case 5: { const int h = n >> 8, r = n & 255; return (r < 128) ? h * 128 + r : 1024 + h * 128 + (r - 128); }
        default: return n;
    }
}
__device__ __forceinline__ void tr_item(const float* W, int K, int N, bf16_t* WT, int kind, const float* gk, LAS float* scr, int item, int lane) {
    const int nblk = (N + 31) >> 5, kb = item / nblk, nb = item - kb * nblk, k0 = 64 * kb, n0 = 32 * nb;
    const int nn = n0 + (lane & 31); const bool ok = nn < N;
#pragma unroll 8
    for (int i = 0; i < 32; ++i) { const int kk = 2 * i + (lane >> 5); float v = ok ? W[(size_t)(k0 + kk) * N + nn] : 0.f; if (gk) v *= gk[k0 + kk]; scr[kk * 33 + (lane & 31)] = v; }
    LDS_WAIT(); asm volatile("" ::: "memory");
    const int c = lane & 7;
#pragma unroll
    for (int j = 0; j < 4; ++j) { const int n = (lane >> 3) + 8 * j; const LAS float* s = scr + (8 * c) * 33 + n;
        u32x4 o; o.x = cvt_pk_bf16(s[0 * 33], s[1 * 33]); o.y = cvt_pk_bf16(s[2 * 33], s[3 * 33]); o.z = cvt_pk_bf16(s[4 * 33], s[5 * 33]); o.w = cvt_pk_bf16(s[6 * 33], s[7 * 33]);
        if (n0 + n < N) *(u32x4*)(WT + (size_t)map_row(kind, n0 + n) * K + k0 + 8 * c) = o; }
    LDS_WAIT(); asm volatile("" ::: "memory");
}

struct Args { const float* in[27]; float* out; unsigned char* ws; };

constexpr int AK_STRIDE = 400, AV_STRIDE = 144, AK_BUF = 64 * AK_STRIDE, AV_BUF = 128 * AV_STRIDE, AV_OFF = 2 * AK_BUF;
__device__ __forceinline__ void attn_unit(const bf16_t* QA, const bf16_t* KN, const bf16_t* P, const bf16_t* VT, bf16_t* HM, int b, int h, int qb, LAS unsigned char* lds, int tid, int wave, int lane) {
    const int tok0 = b * SEQ, q0 = qb * 256 + wave * 32, ql = lane & 31, hh = lane >> 5;
    bf16x8 qf[12];
    { const bf16_t* qp = QA + (size_t)(tok0 + q0 + ql) * 1536 + h * 192 + 8 * hh;
#pragma unroll
      for (int kb = 0; kb < 12; ++kb) qf[kb] = *(const bf16x8*)(qp + 16 * kb); }
    f32x16 o[4];
#pragma unroll
    for (int e = 0; e < 4; ++e)
#pragma unroll
        for (int r = 0; r < 16; ++r) o[e][r] = 0.f;
    float mrun = -1e30f, lrun = 0.f;
    const int ntiles = 4 * (qb + 1);
    const bf16_t* KNb = KN + (size_t)tok0 * 1024 + h * 128; const bf16_t* KRb = P + (size_t)tok0 * NIN + COL_KR; const bf16_t* VTb = VT + (size_t)(h * 128) * M + tok0;
    int ksrc[3], kdst[3], vsrc[2], vdst[2];
#pragma unroll
    for (int i = 0; i < 2; ++i) { const int c = tid + 512 * i, key = c >> 4, cc = c & 15; ksrc[i] = key * 1024 + 8 * cc; kdst[i] = key * AK_STRIDE + cc * 16; }
    { const int key = tid >> 3, cc = tid & 7; ksrc[2] = key * NIN + 8 * cc; kdst[2] = key * AK_STRIDE + (16 + cc) * 16; }
#pragma unroll
    for (int i = 0; i < 2; ++i) { const int c = tid + 512 * i, e = c >> 3, cc = c & 7; vsrc[i] = e * M + 8 * cc; vdst[i] = AV_OFF + e * AV_STRIDE + cc * 16; }
    u32x4 kr[3], vr[2];
#pragma unroll
    for (int i = 0; i < 3; ++i) kr[i] = *(const u32x4*)((i < 2 ? KNb : KRb) + ksrc[i]);
#pragma unroll
    for (int i = 0; i < 2; ++i) vr[i] = *(const u32x4*)(VTb + vsrc[i]);
#pragma unroll
    for (int i = 0; i < 3; ++i) *(LAS u32x4*)(lds + kdst[i]) = kr[i];
#pragma unroll
    for (int i = 0; i < 2; ++i) *(LAS u32x4*)(lds + vdst[i]) = vr[i];
    __syncthreads();
    for (int kt = 0; kt < ntiles; ++kt) {
        const int cur = kt & 1;
        const bool more = (kt + 1 < ntiles);
        if (more) {
#pragma unroll
            for (int i = 0; i < 3; ++i) kr[i] = *(const u32x4*)((i < 2 ? KNb + (size_t)(kt + 1) * 65536 : KRb + (size_t)(kt + 1) * (64 * NIN)) + ksrc[i]);
#pragma unroll
            for (int i = 0; i < 2; ++i) vr[i] = *(const u32x4*)(VTb + (kt + 1) * 64 + vsrc[i]);
        }
        if (kt * 64 <= q0 + 31) {
            const LAS unsigned char* kb_ = lds + cur * AK_BUF;
            const LAS unsigned char* vb_ = lds + AV_OFF + cur * AV_BUF;
            f32x16 st[2];
#pragma unroll
            for (int t = 0; t < 2; ++t) {
#pragma unroll
                for (int r = 0; r < 16; ++r) st[t][r] = 0.f;
#pragma unroll
                for (int kb = 0; kb < 12; ++kb) {
                    const bf16x8 a = *(const LAS bf16x8*)(kb_ + (32 * t + ql) * AK_STRIDE + (16 * kb + 8 * hh) * 2);
                    st[t] = __builtin_amdgcn_mfma_f32_32x32x16_bf16(a, qf[kb], st[t], 0, 0, 0);
                }
            }
            if (kt * 64 + 63 > q0) {
                const int qpos = q0 + ql;
#pragma unroll
                for (int t = 0; t < 2; ++t)
#pragma unroll
                    for (int r = 0; r < 16; ++r) { const int key = kt * 64 + 32 * t + (r & 3) + 8 * (r >> 2) + 4 * hh; if (key > qpos) st[t][r] = -1e30f; }
            }
            float mx = -1e30f;
#pragma unroll
            for (int t = 0; t < 2; ++t)
#pragma unroll
                for (int r = 0; r < 16; ++r) mx = fmaxf(mx, st[t][r]);
            mx = fmaxf(mx, __shfl_xor(mx, 32));
            const float mnew = fmaxf(mrun, mx), alpha = __builtin_amdgcn_exp2f(mrun - mnew);
            float rs = 0.f;
#pragma unroll
            for (int t = 0; t < 2; ++t)
#pragma unroll
                for (int r = 0; r < 16; ++r) { const float p = __builtin_amdgcn_exp2f(st[t][r] - mnew); st[t][r] = p; rs += p; }
            rs += __shfl_xor(rs, 32);
            lrun = lrun * alpha + rs; mrun = mnew;
#pragma unroll
            for (int e = 0; e < 4; ++e)
#pragma unroll
                for (int r = 0; r < 16; ++r) o[e][r] *= alpha;
#pragma unroll
            for (int t = 0; t < 2; ++t) {
                bf16x8 pb[2];
#pragma unroll
                for (int kb = 0; kb < 2; ++kb) {
                    u32x4 w;
                    w.x = cvt_pk_bf16(st[t][8 * kb + 0], st[t][8 * kb + 1]); w.y = cvt_pk_bf16(st[t][8 * kb + 2], st[t][8 * kb + 3]);
                    w.z = cvt_pk_bf16(st[t][8 * kb + 4], st[t][8 * kb + 5]); w.w = cvt_pk_bf16(st[t][8 * kb + 6], st[t][8 * kb + 7]);
                    pb[kb] = __builtin_bit_cast(bf16x8, w);
                }
#pragma unroll
                for (int e = 0; e < 4; ++e)
#pragma unroll
                    for (int kb = 0; kb < 2; ++kb) {
                        const LAS unsigned char* vp = vb_ + (32 * e + ql) * AV_STRIDE + (16 * (2 * t + kb) + 4 * hh) * 2;
                        const u32x2 lo = *(const LAS u32x2*)vp, hi = *(const LAS u32x2*)(vp + 16);
                        const u32x4 av = {lo.x, lo.y, hi.x, hi.y};
                        o[e] = __builtin_amdgcn_mfma_f32_32x32x16_bf16(__builtin_bit_cast(bf16x8, av), pb[kb], o[e], 0, 0, 0);
                    }
            }
        }
        if (more) {
            LAS unsigned char* kw = lds + (cur ^ 1) * AK_BUF; LAS unsigned char* vw = lds + (cur ^ 1) * AV_BUF;
#pragma unroll
            for (int i = 0; i < 3; ++i) *(LAS u32x4*)(kw + kdst[i]) = kr[i];
#pragma unroll
            for (int i = 0; i < 2; ++i) *(LAS u32x4*)(vw + vdst[i]) = vr[i];
        }
        __syncthreads();
    }
    const float inv = 1.0f / lrun;
    bf16_t* op = HM + (size_t)(tok0 + q0 + ql) * D + 1024 + h * 128 + 4 * hh;
#pragma unroll
    for (int e = 0; e < 4; ++e)
#pragma unroll
        for (int g = 0; g < 4; ++g) {
            u32x2 w; w.x = cvt_pk_bf16(o[e][4 * g + 0] * inv, o[e][4 * g + 1] * inv); w.y = cvt_pk_bf16(o[e][4 * g + 2] * inv, o[e][4 * g + 3] * inv);
            *(u32x2*)(op + 32 * e + 8 * g) = w;
        }
}

constexpr int MK_STRIDE = 272, MK_BUF = 64 * MK_STRIDE, MV_OFF = 2 * MK_BUF, ME_OFF = MV_OFF + 2 * AV_BUF;
__device__ __forceinline__ void mlp_unit(const bf16_t* QC, const bf16_t* KC, const bf16_t* VTM, const float* EG, const float* MG, float* HRAW, int b, int h, int qb, int eh, LAS unsigned char* lds, int tid, int wave, int lane) {
    const int tok0 = b * SEQ, q0 = qb * 256 + wave * 32, ql = lane & 31, hh = lane >> 5, bh = b * 4 + h;
    bf16x8 qf[8];
    { const bf16_t* qp = QC + (size_t)(tok0 + q0 + ql) * 512 + h * 128 + 8 * hh;
#pragma unroll
      for (int kb = 0; kb < 8; ++kb) qf[kb] = *(const bf16x8*)(qp + 16 * kb); }
    const float mg = MG[bh * SEQ + q0 + ql];
    f32x16 o[4];
#pragma unroll
    for (int e = 0; e < 4; ++e)
#pragma unroll
        for (int r = 0; r < 16; ++r) o[e][r] = 0.f;
    const int ntiles = 4 * (qb + 1);
    const bf16_t* KCb = KC + (size_t)tok0 * 512 + h * 128; const bf16_t* VTb = VTM + (size_t)(h * 256 + eh * 128) * M + tok0; const float* EGb = EG + bh * SEQ;
    int ksrc[2], kdst[2], vsrc[2], vdst[2];
#pragma unroll
    for (int i = 0; i < 2; ++i) { const int c = tid + 512 * i, key = c >> 4, cc = c & 15; ksrc[i] = key * 512 + 8 * cc; kdst[i] = key * MK_STRIDE + cc * 16; }
#pragma unroll
    for (int i = 0; i < 2; ++i) { const int c = tid + 512 * i, e = c >> 3, cc = c & 7; vsrc[i] = e * M + 8 * cc; vdst[i] = MV_OFF + e * AV_STRIDE + cc * 16; }
    u32x4 kr[2], vr[2]; float er = 0.f;
#pragma unroll
    for (int i = 0; i < 2; ++i) kr[i] = *(const u32x4*)(KCb + ksrc[i]);
#pragma unroll
    for (int i = 0; i < 2; ++i) vr[i] = *(const u32x4*)(VTb + vsrc[i]);
    if (tid < 64) er = EGb[tid];
#pragma unroll
    for (int i = 0; i < 2; ++i) *(LAS u32x4*)(lds + kdst[i]) = kr[i];
#pragma unroll
    for (int i = 0; i < 2; ++i) *(LAS u32x4*)(lds + vdst[i]) = vr[i];
    if (tid < 64) *(LAS float*)(lds + ME_OFF + 4 * tid) = er;
    __syncthreads();
    for (int kt = 0; kt < ntiles; ++kt) {
        const int cur = kt & 1;
        const bool more = (kt + 1 < ntiles);
        if (more) {
#pragma unroll
            for (int i = 0; i < 2; ++i) kr[i] = *(const u32x4*)(KCb + (size_t)(kt + 1) * (64 * 512) + ksrc[i]);
#pragma unroll
            for (int i = 0; i < 2; ++i) vr[i] = *(const u32x4*)(VTb + (kt + 1) * 64 + vsrc[i]);
            if (tid < 64) er = EGb[(kt + 1) * 64 + tid];
        }
        if (kt * 64 <= q0 + 31) {
            const LAS unsigned char* kb_ = lds + cur * MK_BUF;
            const LAS unsigned char* vb_ = lds + MV_OFF + cur * AV_BUF;
            const LAS unsigned char* eb_ = lds + ME_OFF + cur * 256;
            const int qpos = q0 + ql;
#pragma unroll
            for (int t = 0; t < 2; ++t) {
                f32x16 st;
#pragma unroll
                for (int r = 0; r < 16; ++r) st[r] = 0.f;
#pragma unroll
                for (int kb = 0; kb < 8; ++kb) {
                    const bf16x8 a = *(const LAS bf16x8*)(kb_ + (32 * t + ql) * MK_STRIDE + (16 * kb + 8 * hh) * 2);
                    st = __builtin_amdgcn_mfma_f32_32x32x16_bf16(a, qf[kb], st, 0, 0, 0);
                }
#pragma unroll
                for (int g = 0; g < 4; ++g) {
                    const f32x4 ev = *(const LAS f32x4*)(eb_ + 4 * (32 * t + 8 * g + 4 * hh));
#pragma unroll
                    for (int i = 0; i < 4; ++i) {
                        const int key = kt * 64 + 32 * t + 8 * g + 4 * hh + i;
                        const float w = __builtin_amdgcn_exp2f(fminf(ev[i] - mg, 0.f));
                        st[4 * g + i] = (key <= qpos) ? st[4 * g + i] * w : 0.f;
                    }
                }
                bf16x8 pb[2];
#pragma unroll
                for (int kb = 0; kb < 2; ++kb) {
                    u32x4 w;
                    w.x = cvt_pk_bf16(st[8 * kb + 0], st[8 * kb + 1]); w.y = cvt_pk_bf16(st[8 * kb + 2], st[8 * kb + 3]);
                    w.z = cvt_pk_bf16(st[8 * kb + 4], st[8 * kb + 5]); w.w = cvt_pk_bf16(st[8 * kb + 6], st[8 * kb + 7]);
                    pb[kb] = __builtin_bit_cast(bf16x8, w);
                }
#pragma unroll
                for (int e = 0; e < 4; ++e)
#pragma unroll
                    for (int kb = 0; kb < 2; ++kb) {
                        const LAS unsigned char* vp = vb_ + (32 * e + ql) * AV_STRIDE + (16 * (2 * t + kb) + 4 * hh) * 2;
                        const u32x2 lo = *(const LAS u32x2*)vp, hi = *(const LAS u32x2*)(vp + 16);
                        const u32x4 av = {lo.x, lo.y, hi.x, hi.y};
                        o[e] = __builtin_amdgcn_mfma_f32_32x32x16_bf16(__builtin_bit_cast(bf16x8, av), pb[kb], o[e], 0, 0, 0);
                    }
            }
        }
        if (more) {
            LAS unsigned char* kw = lds + (cur ^ 1) * MK_BUF; LAS unsigned char* vw = lds + (cur ^ 1) * AV_BUF;
#pragma unroll
            for (int i = 0; i < 2; ++i) *(LAS u32x4*)(kw + kdst[i]) = kr[i];
#pragma unroll
            for (int i = 0; i < 2; ++i) *(LAS u32x4*)(vw + vdst[i]) = vr[i];
            if (tid < 64) *(LAS float*)(lds + ME_OFF + (cur ^ 1) * 256 + 4 * tid) = er;
        }
        __syncthreads();
    }
    float* op = HRAW + (size_t)(tok0 + q0 + ql) * 1024 + h * 256 + eh * 128 + 4 * hh;
#pragma unroll
    for (int e = 0; e < 4; ++e)
#pragma unroll
        for (int g = 0; g < 4; ++g) {
            const f32x4 w = {o[e][4 * g + 0], o[e][4 * g + 1], o[e][4 * g + 2], o[e][4 * g + 3]};
            *(f32x4*)(op + 32 * e + 8 * g) = w;
        }
}

__global__ void __launch_bounds__(512, 2) fwd_kernel(Args args) {
    extern __shared__ __attribute__((aligned(16))) unsigned char lds_raw[];
    LAS unsigned char* lds = (LAS unsigned char*)lds_raw;
    cg::grid_group grid = cg::this_grid();
    const int G = gridDim.x, bid = blockIdx.x, NGW = G * 8;
#define GRID_SYNC() do { asm volatile("s_waitcnt vmcnt(0)" ::: "memory"); __syncthreads(); grid.sync(); } while (0)
#define PH_THREAD() const int tid = opaque_tid(), lane = tid & 63, wave = __builtin_amdgcn_readfirstlane(tid >> 6), gw = bid * 8 + wave; (void)lane; (void)gw; (void)tid
    unsigned char* ws = args.ws;
    const float* x_in = args.in[0];
    float* MOD = (float*)(ws + WS_MOD); f32x2* ROPE = (f32x2*)(ws + WS_ROPE); float* GATES = (float*)(ws + WS_GATES);
    bf16_t* U = (bf16_t*)(ws + WS_U); float* Z = (float*)(ws + WS_Z); float* X = (float*)(ws + WS_X);
    bf16_t* Hb = (bf16_t*)(ws + WS_H); bf16_t* P = (bf16_t*)(ws + WS_P); bf16_t* QA = (bf16_t*)(ws + WS_QA); bf16_t* KN = (bf16_t*)(ws + WS_KN);
    bf16_t* VT = (bf16_t*)(ws + WS_VT); bf16_t* HM = (bf16_t*)(ws + WS_HM); float* HRAW = (float*)(ws + WS_HRAW);
    bf16_t* QC = (bf16_t*)(ws + WS_QC); bf16_t* KC = (bf16_t*)(ws + WS_KC); bf16_t* VTM = (bf16_t*)(ws + WS_VTM); float* EG = (float*)(ws + WS_EG); float* MG = (float*)(ws + WS_MG);

    { constexpr int ph = 0; PH_THREAD();
            if (bid < 144) {
                LAS float* sc = (LAS float*)lds; LAS float* red = sc + 8192;
                const float* c = args.in[1]; const float* w_ada = args.in[2]; const float* b_ada = args.in[3];
                for (int i = tid; i < 8192; i += 512) { const float v = c[i]; sc[i] = v / (1.f + expf(-v)); }
                __syncthreads();
                const int col = bid * 128 + 2 * lane;
                float a[4][2];
#pragma unroll
                for (int b = 0; b < 4; ++b) { a[b][0] = 0.f; a[b][1] = 0.f; }
                const float* wp = w_ada + (size_t)(256 * wave) * NMOD + col;
#pragma unroll 8
                for (int k = 0; k < 256; ++k) {
                    const f32x2 v = *(const f32x2*)(wp + (size_t)k * NMOD);
#pragma unroll
                    for (int b = 0; b < 4; ++b) { const float s = sc[b * 2048 + 256 * wave + k]; a[b][0] += s * v.x; a[b][1] += s * v.y; }
                }
#pragma unroll
                for (int b = 0; b < 4; ++b) { red[(wave * 4 + b) * 128 + 2 * lane] = a[b][0]; red[(wave * 4 + b) * 128 + 2 * lane + 1] = a[b][1]; }
                __syncthreads();
                { const int b = tid >> 7, cc = tid & 127; float s = b_ada[bid * 128 + cc];
#pragma unroll
                  for (int w = 0; w < 8; ++w) s += red[(w * 4 + b) * 128 + cc];
                  MOD[(size_t)b * NMOD + bid * 128 + cc] = s; }
                __syncthreads();
            }
            for (int i = bid * 512 + tid; i < SEQ * 32; i += G * 512) {
                const int s = i >> 5, j = i & 31;
                const float inv = (float)pow(10000.0, -(double)j / 32.0);
                const float ang = (float)s * inv;
                const double rev = (double)ang * 0.15915494309189535; const float fr_ = (float)(rev - rint(rev));
                ROPE[i] = (f32x2){__builtin_amdgcn_cosf(fr_), __builtin_amdgcn_sinf(fr_)};
            }
            LAS float* scr = (LAS float*)(lds + 49152 + wave * 8448);
            constexpr int I_UP = 32 * 176, I_DN = 88 * 64, I_IN = 32 * 123, I_UQ = 8 * 48, I_KV = 4 * 64, I_WO = 32 * 64;
            constexpr int NIT = 4 * I_UP + 2 * I_DN + I_IN + I_UQ + I_KV + I_WO;
            for (int it = gw; it < NIT; it += NGW) {
                int r = it;
                if (r < I_UP) { tr_item(args.in[4], D, FF, (bf16_t*)(ws + WS_W13A), 0, nullptr, scr, r, lane); continue; } r -= I_UP;
                if (r < I_UP) { tr_item(args.in[5], D, FF, (bf16_t*)(ws + WS_W13A), 1, nullptr, scr, r, lane); continue; } r -= I_UP;
                if (r < I_DN) { tr_item(args.in[6], FF, D, (bf16_t*)(ws + WS_W2A), 2, nullptr, scr, r, lane); continue; } r -= I_DN;
                if (r < I_IN) { tr_item(args.in[9], D, DIN, (bf16_t*)(ws + WS_WIN), 3, nullptr, scr, r, lane); continue; } r -= I_IN;
                if (r < I_UQ) { tr_item(args.in[16], 512, 1536, (bf16_t*)(ws + WS_WUQ), 4, args.in[15], scr, r, lane); continue; } r -= I_UQ;
                if (r < I_KV) { tr_item(args.in[18], 256, 2048, (bf16_t*)(ws + WS_WK), 5, args.in[17], scr, r, lane); continue; } r -= I_KV;
                if (r < I_WO) { tr_item(args.in[19], D, D, (bf16_t*)(ws + WS_WOUT), 2, nullptr, scr, r, lane); continue; } r -= I_WO;
                if (r < I_UP) { tr_item(args.in[22], D, FF, (bf16_t*)(ws + WS_W13B), 0, nullptr, scr, r, lane); continue; } r -= I_UP;
                if (r < I_UP) { tr_item(args.in[23], D, FF, (bf16_t*)(ws + WS_W13B), 1, nullptr, scr, r, lane); continue; } r -= I_UP;
                tr_item(args.in[24], FF, D, (bf16_t*)(ws + WS_W2B), 2, nullptr, scr, r, lane);
            }
            }
    GRID_SYNC();
    { constexpr int ph = 1; PH_THREAD();
            for (int row = gw; row < M; row += NGW) {
                const int b = row >> 11; const float* mb = MOD + (size_t)b * NMOD;
                const f32x4* xr = (const f32x4*)(x_in + (size_t)row * D) + lane; u32x2* ur = (u32x2*)(U + (size_t)row * D) + lane;
#pragma unroll
                for (int j = 0; j < 8; ++j) { const f32x4 v = xr[64 * j]; const f32x4 sh = *((const f32x4*)mb + lane + 64 * j), scl = *((const f32x4*)(mb + 2048) + lane + 64 * j);
                    const f32x4 y = v * (scl + 1.0f) + sh; u32x2 w; w.x = cvt_pk_bf16(y[0], y[1]); w.y = cvt_pk_bf16(y[2], y[3]); ur[64 * j] = w; }
            }
            }
    GRID_SYNC();
    { constexpr int ph = 2; PH_THREAD();
            const bf16_t* Wt = (const bf16_t*)(ws + (ph == 2 ? WS_W13A : WS_W13B));
            pg8::Gemm g{U, Wt, D, D, D}; pg8::StaticOrder S; S.init(M, 2 * FF, G, bid);
            pg8::EpiSwiglu E{Hb};
            pg8::gemm_phase<pg8::EpiSwiglu, pg8::StaticOrder, true>(lds, g, S, E);
            }
    GRID_SYNC();
    { constexpr int ph = 3; PH_THREAD();
            const int s = (ph == 3) ? 0 : (ph == 9 ? 1 : 2);
            const bf16_t* A = (ph == 9) ? HM : Hb; const bf16_t* Wt = (const bf16_t*)(ws + (ph == 3 ? WS_W2A : (ph == 9 ? WS_WOUT : WS_W2B)));
            const int K = (ph == 9) ? D : FF;
            const float* Xr = (ph == 3) ? x_in : X;
            pg8::Gemm g{A, Wt, K, K, K}; pg8::StaticOrder S; S.init(M, D, G, bid);
            pg8::EpiResid E{Xr, Z, MOD + s * 6144 + 4096, (ph == 9) ? 1.0f : 0.5f};
            pg8::gemm_phase<pg8::EpiResid, pg8::StaticOrder, true>(lds, g, S, E);
            }
    GRID_SYNC();
    { constexpr int ph = 4; PH_THREAD();
            const int s = (ph == 4) ? 1 : 2;
            const float* gp = args.in[ph == 4 ? 7 : (ph == 10 ? 20 : 25)]; const float* bp = args.in[ph == 4 ? 8 : (ph == 10 ? 21 : 26)];
            float* Xo = (ph == 13) ? args.out : X;
            for (int row = gw; row < M; row += NGW) {
                const int b = row >> 11; const float* mb = MOD + (size_t)b * NMOD + s * 6144;
                const f32x4* zr = (const f32x4*)(Z + (size_t)row * D) + lane;
                f32x4 v[8]; float sm = 0.f;
#pragma unroll
                for (int j = 0; j < 8; ++j) { v[j] = zr[64 * j]; sm += (v[j][0] + v[j][1]) + (v[j][2] + v[j][3]); }
                const float mean = wave_sum(sm) * (1.f / D); float s2 = 0.f;
#pragma unroll
                for (int j = 0; j < 8; ++j) { v[j] = v[j] - mean; s2 += (v[j][0] * v[j][0] + v[j][1] * v[j][1]) + (v[j][2] * v[j][2] + v[j][3] * v[j][3]); }
                const float rstd = 1.f / sqrtf(wave_sum(s2) * (1.f / D) + LN_EPS);
                f32x4* xo = (f32x4*)(Xo + (size_t)row * D) + lane; u32x2* ur = (u32x2*)(U + (size_t)row * D) + lane;
#pragma unroll
                for (int j = 0; j < 8; ++j) {
                    const f32x4 gg = *((const f32x4*)gp + lane + 64 * j), bb = *((const f32x4*)bp + lane + 64 * j);
                    const f32x4 y = v[j] * rstd * gg + bb; xo[64 * j] = y;
                    if (ph != 13) { const f32x4 sh = *((const f32x4*)mb + lane + 64 * j), scl = *((const f32x4*)(mb + 2048) + lane + 64 * j);
                        const f32x4 uu = y * (scl + 1.0f) + sh; u32x2 w; w.x = cvt_pk_bf16(uu[0], uu[1]); w.y = cvt_pk_bf16(uu[2], uu[3]); ur[64 * j] = w; }
                }
            }
            }
    GRID_SYNC();
    { constexpr int ph = 5; PH_THREAD();
            pg8::Gemm g{U, (const bf16_t*)(ws + WS_WIN), D, D, D}; pg8::StaticOrder S; S.init(M, NIN, G, bid);
            pg8::EpiWin E{P, GATES, ROPE};
            pg8::gemm_phase<pg8::EpiWin, pg8::StaticOrder, true>(lds, g, S, E);
            }
    GRID_SYNC();
    { constexpr int ph = 6; PH_THREAD();
            LAS float* tab = (LAS float*)(lds + TAB_OFF);
            for (int L = bid; L < 448; L += G) {
                int mode, pm, pn;
                if (L < 192) { mode = 0; pm = L / 6; pn = L % 6; } else if (L < 320) { mode = 1; pm = (L - 192) >> 2; pn = (L - 192) & 3; } else { mode = 2; pm = (L - 320) & 3; pn = (L - 320) >> 2; }
                const int t0 = ((mode == 2) ? pn : pm) * 256;
                __syncthreads();
                for (int r = 0; r < 32; ++r) {
                    const bf16_t* pr = P + (size_t)(t0 + 32 * wave + r) * NIN; float ss;
                    if (mode == 0) { const u32x4 w = *(const u32x4*)(pr + COL_CQ + 8 * lane); const float a0 = bflo(w.x), a1 = bfhi(w.x), a2 = bflo(w.y), a3 = bfhi(w.y), a4 = bflo(w.z), a5 = bfhi(w.z), a6 = bflo(w.w), a7 = bfhi(w.w);
                        ss = (a0 * a0 + a1 * a1) + (a2 * a2 + a3 * a3) + (a4 * a4 + a5 * a5) + (a6 * a6 + a7 * a7); }
                    else { const u32x2 w = *(const u32x2*)(pr + COL_CKV + 4 * lane); const float a0 = bflo(w.x), a1 = bfhi(w.x), a2 = bflo(w.y), a3 = bfhi(w.y); ss = (a0 * a0 + a1 * a1) + (a2 * a2 + a3 * a3); }
                    ss = wave_sum(ss);
                    if (lane == 0) tab[32 * wave + r] = 1.f / sqrtf(ss * (mode == 0 ? 1.f / 512.f : 1.f / 256.f) + LN_EPS);
                }
                __syncthreads();
                pg8::Gemm g;
                if (mode == 0) g = pg8::Gemm{P + COL_CQ, (const bf16_t*)(ws + WS_WUQ), NIN, 512, 512};
                else if (mode == 1) g = pg8::Gemm{P + COL_CKV, (const bf16_t*)(ws + WS_WK), NIN, 256, 256};
                else g = pg8::Gemm{(const bf16_t*)(ws + WS_WV), P + COL_CKV, 256, NIN, 256};
                pg8::SingleUnit S; S.u0.pm = pm; S.u0.pn = pn;
                pg8::EpiLR E{mode, mode == 0 ? QA : (mode == 1 ? KN : VT), mode == 0 ? 1536 : (mode == 1 ? 1024 : M), tab, ROPE};
                pg8::gemm_phase<pg8::EpiLR, pg8::SingleUnit, false>(lds, g, S, E);
            }
            __syncthreads();
            {
                const float* conv_w = args.in[10]; const float* conv_b = args.in[11];
                for (int idx = bid * 512 + tid; idx < M * 128; idx += G * 512) {
                    const int row = idx >> 7, cgp = idx & 127, ch0 = 8 * cgp, sq = row & (SEQ - 1);
                    u32x4 xr[4];
#pragma unroll
                    for (int r = 0; r < 4; ++r) xr[r] = (sq - 3 + r >= 0) ? *(const u32x4*)(P + (size_t)(row - 3 + r) * NIN + ch0) : (u32x4){0u, 0u, 0u, 0u};
                    const float ksc = (ch0 < 512) ? 1.0f : 0.08838834764831845f;
                    unsigned ow[4];
#pragma unroll
                    for (int wd = 0; wd < 4; ++wd) {
                        float x0[4], x1[4];
#pragma unroll
                        for (int r = 0; r < 4; ++r) { const unsigned w = (wd == 0) ? xr[r].x : (wd == 1) ? xr[r].y : (wd == 2) ? xr[r].z : xr[r].w; x0[r] = bflo(w); x1[r] = bfhi(w); }
                        const int c0 = ch0 + 2 * wd;
                        float a0 = conv_b[c0], a1 = conv_b[c0 + 1];
#pragma unroll
                        for (int j = 0; j < 4; ++j) { a0 += conv_w[j * 1024 + c0] * x0[j]; a1 += conv_w[j * 1024 + c0 + 1] * x1[j]; }
                        ow[wd] = cvt_pk_bf16(silu_f(a0) * ksc, silu_f(a1) * ksc);
                    }
                    const u32x4 w = {ow[0], ow[1], ow[2], ow[3]};
                    if (ch0 < 512) *(u32x4*)(QC + (size_t)row * 512 + ch0) = w; else *(u32x4*)(KC + (size_t)row * 512 + (ch0 - 512)) = w;
                }
                LAS unsigned char* tl = lds + wave * 9216;
                for (int tix = gw; tix < 128 * 16; tix += NGW) {
                    const int tt = tix >> 4, et = tix & 15;
#pragma unroll
                    for (int c = 0; c < 8; ++c) {
                        const u32x4 v = *(const u32x4*)(P + (size_t)(tt * 64 + lane) * NIN + 1024 + et * 64 + 8 * c);
                        const unsigned wv[4] = {v.x, v.y, v.z, v.w};
#pragma unroll
                        for (int i = 0; i < 4; ++i) { *(LAS bf16_t*)(tl + (8 * c + 2 * i) * 144 + 2 * lane) = (bf16_t)(wv[i] & 0xffffu); *(LAS bf16_t*)(tl + (8 * c + 2 * i + 1) * 144 + 2 * lane) = (bf16_t)(wv[i] >> 16); }
                    }
                    LDS_WAIT(); asm volatile("" ::: "memory");
#pragma unroll
                    for (int c = 0; c < 8; ++c) { const u32x4 v = *(const LAS u32x4*)(tl + lane * 144 + 16 * c); *(u32x4*)(VTM + (size_t)(et * 64 + lane) * M + tt * 64 + 8 * c) = v; }
                    LDS_WAIT(); asm volatile("" ::: "memory");
                }
                if (gw < 16) {
                    const int b = gw >> 2, h = gw & 3; const float big = args.in[12][h], bfg = args.in[13][h];
                    float Fc = 0.f, Mc = -1e30f;
                    for (int ch = 0; ch < 32; ++ch) {
                        const int tok = b * SEQ + ch * 64 + lane;
                        const float ip = GATES[(size_t)tok * 8 + h] + big, fp = GATES[(size_t)tok * 8 + 4 + h] + bfg;
                        float bc = fminf(fp, 0.f) - log1pf(__expf(-fabsf(fp)));
#pragma unroll
                        for (int d = 1; d < 64; d <<= 1) { const float t = __shfl_up(bc, d); if (lane >= d) bc += t; }
                        bc += Fc;
                        const float ej = (ip - bc) * 1.4426950408889634f;
                        float pmx = ej;
#pragma unroll
                        for (int d = 1; d < 64; d <<= 1) { const float t = __shfl_up(pmx, d); if (lane >= d) pmx = fmaxf(pmx, t); }
                        pmx = fmaxf(pmx, Mc);
                        EG[gw * SEQ + ch * 64 + lane] = ej; MG[gw * SEQ + ch * 64 + lane] = pmx;
                        Fc = __shfl(bc, 63); Mc = __shfl(pmx, 63);
                    }
                }
            }
            }
    GRID_SYNC();
    { constexpr int ph = 7; PH_THREAD();
#if !DBG_NO_MLSTM
            for (int it = bid; it < 128; it += G) {
                const int bh = it >> 3, eh = (it >> 2) & 1, pr = it & 3;
                mlp_unit(QC, KC, VTM, EG, MG, HRAW, bh >> 2, bh & 3, 7 - pr, eh, lds, tid, wave, lane);
                mlp_unit(QC, KC, VTM, EG, MG, HRAW, bh >> 2, bh & 3, pr, eh, lds, tid, wave, lane);
            }
#endif
#if !DBG_NO_ATTN
            for (int it = bid; it < 256; it += G) {
                if (it < 128) continue;
                const int a = it - 128, bh = a >> 2, pr = a & 3;
                attn_unit(QA, KN, P, VT, HM, bh >> 3, bh & 7, 7 - pr, lds, tid, wave, lane);
                attn_unit(QA, KN, P, VT, HM, bh >> 3, bh & 7, pr, lds, tid, wave, lane);
            }
#endif
    }
    GRID_SYNC();
    { constexpr int ph = 8; PH_THREAD();
            const float* mg = args.in[14];
            for (int row = gw; row < M; row += NGW) {
#pragma unroll
                for (int hh = 0; hh < 4; ++hh) {
#if DBG_NO_MLSTM
                    f32x4 v = {0.f, 0.f, 0.f, 0.f};
#else
                    f32x4 v = *((const f32x4*)(HRAW + (size_t)row * 1024 + hh * 256) + lane);
#endif
                    const float mean = wave_sum((v[0] + v[1]) + (v[2] + v[3])) * (1.f / 256.f);
                    v = v - mean;
                    const float rstd = 1.f / sqrtf(wave_sum((v[0] * v[0] + v[1] * v[1]) + (v[2] * v[2] + v[3] * v[3])) * (1.f / 256.f) + LN_EPS);
                    const f32x4 gg = *((const f32x4*)(mg + hh * 256) + lane);
                    const u32x2 ow = *((const u32x2*)(P + (size_t)row * NIN + 2048 + hh * 256) + lane);
                    const float o0 = bflo(ow.x), o1 = bfhi(ow.x), o2 = bflo(ow.y), o3 = bfhi(ow.y);
                    f32x4 y = v * rstd * gg;
                    y[0] *= 1.f / (1.f + __expf(-o0)); y[1] *= 1.f / (1.f + __expf(-o1)); y[2] *= 1.f / (1.f + __expf(-o2)); y[3] *= 1.f / (1.f + __expf(-o3));
                    u32x2 w; w.x = cvt_pk_bf16(y[0], y[1]); w.y = cvt_pk_bf16(y[2], y[3]);
                    *((u32x2*)(HM + (size_t)row * D + hh * 256) + lane) = w;
#if DBG_NO_ATTN
                    *((u32x2*)(HM + (size_t)row * D + 1024 + hh * 256) + lane) = (u32x2){0u, 0u};
#endif
                }
            }
            }
    GRID_SYNC();
    { constexpr int ph = 9; PH_THREAD();
            const int s = (ph == 3) ? 0 : (ph == 9 ? 1 : 2);
            const bf16_t* A = (ph == 9) ? HM : Hb; const bf16_t* Wt = (const bf16_t*)(ws + (ph == 3 ? WS_W2A : (ph == 9 ? WS_WOUT : WS_W2B)));
            const int K = (ph == 9) ? D : FF;
            const float* Xr = (ph == 3) ? x_in : X;
            pg8::Gemm g{A, Wt, K, K, K}; pg8::StaticOrder S; S.init(M, D, G, bid);
            pg8::EpiResid E{Xr, Z, MOD + s * 6144 + 4096, (ph == 9) ? 1.0f : 0.5f};
            pg8::gemm_phase<pg8::EpiResid, pg8::StaticOrder, true>(lds, g, S, E);
            }
    GRID_SYNC();
    { constexpr int ph = 10; PH_THREAD();
            const int s = (ph == 4) ? 1 : 2;
            const float* gp = args.in[ph == 4 ? 7 : (ph == 10 ? 20 : 25)]; const float* bp = args.in[ph == 4 ? 8 : (ph == 10 ? 21 : 26)];
            float* Xo = (ph == 13) ? args.out : X;
            for (int row = gw; row < M; row += NGW) {
                const int b = row >> 11; const float* mb = MOD + (size_t)b * NMOD + s * 6144;
                const f32x4* zr = (const f32x4*)(Z + (size_t)row * D) + lane;
                f32x4 v[8]; float sm = 0.f;
#pragma unroll
                for (int j = 0; j < 8; ++j) { v[j] = zr[64 * j]; sm += (v[j][0] + v[j][1]) + (v[j][2] + v[j][3]); }
                const float mean = wave_sum(sm) * (1.f / D); float s2 = 0.f;
#pragma unroll
                for (int j = 0; j < 8; ++j) { v[j] = v[j] - mean; s2 += (v[j][0] * v[j][0] + v[j][1] * v[j][1]) + (v[j][2] * v[j][2] + v[j][3] * v[j][3]); }
                const float rstd = 1.f / sqrtf(wave_sum(s2) * (1.f / D) + LN_EPS);
                f32x4* xo = (f32x4*)(Xo + (size_t)row * D) + lane; u32x2* ur = (u32x2*)(U + (size_t)row * D) + lane;
#pragma unroll
                for (int j = 0; j < 8; ++j) {
                    const f32x4 gg = *((const f32x4*)gp + lane + 64 * j), bb = *((const f32x4*)bp + lane + 64 * j);
                    const f32x4 y = v[j] * rstd * gg + bb; xo[64 * j] = y;
                    if (ph != 13) { const f32x4 sh = *((const f32x4*)mb + lane + 64 * j), scl = *((const f32x4*)(mb + 2048) + lane + 64 * j);
                        const f32x4 uu = y * (scl + 1.0f) + sh; u32x2 w; w.x = cvt_pk_bf16(uu[0], uu[1]); w.y = cvt_pk_bf16(uu[2], uu[3]); ur[64 * j] = w; }
                }
            }
            }
    GRID_SYNC();
    { constexpr int ph = 11; PH_THREAD();
            const bf16_t* Wt = (const bf16_t*)(ws + (ph == 2 ? WS_W13A : WS_W13B));
            pg8::Gemm g{U, Wt, D, D, D}; pg8::StaticOrder S; S.init(M, 2 * FF, G, bid);
            pg8::EpiSwiglu E{Hb};
            pg8::gemm_phase<pg8::EpiSwiglu, pg8::StaticOrder, true>(lds, g, S, E);
            }
    GRID_SYNC();
    { constexpr int ph = 12; PH_THREAD();
            const int s = (ph == 3) ? 0 : (ph == 9 ? 1 : 2);
            const bf16_t* A = (ph == 9) ? HM : Hb; const bf16_t* Wt = (const bf16_t*)(ws + (ph == 3 ? WS_W2A : (ph == 9 ? WS_WOUT : WS_W2B)));
            const int K = (ph == 9) ? D : FF;
            const float* Xr = (ph == 3) ? x_in : X;
            pg8::Gemm g{A, Wt, K, K, K}; pg8::StaticOrder S; S.init(M, D, G, bid);
            pg8::EpiResid E{Xr, Z, MOD + s * 6144 + 4096, (ph == 9) ? 1.0f : 0.5f};
            pg8::gemm_phase<pg8::EpiResid, pg8::StaticOrder, true>(lds, g, S, E);
            }
    GRID_SYNC();
    { constexpr int ph = 13; PH_THREAD();
            const int s = (ph == 4) ? 1 : 2;
            const float* gp = args.in[ph == 4 ? 7 : (ph == 10 ? 20 : 25)]; const float* bp = args.in[ph == 4 ? 8 : (ph == 10 ? 21 : 26)];
            float* Xo = (ph == 13) ? args.out : X;
            for (int row = gw; row < M; row += NGW) {
                const int b = row >> 11; const float* mb = MOD + (size_t)b * NMOD + s * 6144;
                const f32x4* zr = (const f32x4*)(Z + (size_t)row * D) + lane;
                f32x4 v[8]; float sm = 0.f;
#pragma unroll
                for (int j = 0; j < 8; ++j) { v[j] = zr[64 * j]; sm += (v[j][0] + v[j][1]) + (v[j][2] + v[j][3]); }
                const float mean = wave_sum(sm) * (1.f / D); float s2 = 0.f;
#pragma unroll
                for (int j = 0; j < 8; ++j) { v[j] = v[j] - mean; s2 += (v[j][0] * v[j][0] + v[j][1] * v[j][1]) + (v[j][2] * v[j][2] + v[j][3] * v[j][3]); }
                const float rstd = 1.f / sqrtf(wave_sum(s2) * (1.f / D) + LN_EPS);
                f32x4* xo = (f32x4*)(Xo + (size_t)row * D) + lane; u32x2* ur = (u32x2*)(U + (size_t)row * D) + lane;
#pragma unroll
                for (int j = 0; j < 8; ++j) {
                    const f32x4 gg = *((const f32x4*)gp + lane + 64 * j), bb = *((const f32x4*)bp + lane + 64 * j);
                    const f32x4 y = v[j] * rstd * gg + bb; xo[64 * j] = y;
                    if (ph != 13) { const f32x4 sh = *((const f32x4*)mb + lane + 64 * j), scl = *((const f32x4*)(mb + 2048) + lane + 64 * j);
                        const f32x4 uu = y * (scl + 1.0f) + sh; u32x2 w; w.x = cvt_pk_bf16(uu[0], uu[1]); w.y = cvt_pk_bf16(uu[2], uu[3]); ur[64 * j] = w; }
                }
            }
            }
}

extern "C" void kernel_launch(void* const* d_in, const int* in_sizes, int n_in, void* d_out, int out_size, void* d_ws, size_t ws_size, hipStream_t stream) {
    static int grid = 0;
    if (grid == 0) {
        if (n_in != 27 || out_size != M * D || ws_size < WS_END) { fprintf(stderr, "kernel_launch: unexpected shapes (n_in %d out %d ws %zu need %zu)\n", n_in, out_size, ws_size, (size_t)WS_END); grid = -1; return; }
        int dev = 0, cus = 0, per_cu = 0;
        hipGetDevice(&dev); hipDeviceGetAttribute(&cus, hipDeviceAttributeMultiprocessorCount, dev);
        if (hipFuncSetAttribute((const void*)fwd_kernel, hipFuncAttributeMaxDynamicSharedMemorySize, LDS_BYTES) != hipSuccess) { fprintf(stderr, "kernel_launch: hipFuncSetAttribute failed\n"); grid = -1; return; }
        hipOccupancyMaxActiveBlocksPerMultiprocessor(&per_cu, (const void*)fwd_kernel, 512, LDS_BYTES);
        (void)hipGetLastError();
        if (per_cu < 1) { fprintf(stderr, "kernel_launch: occupancy query says %d blocks/CU\n", per_cu); per_cu = 1; }
        grid = cus;
    }
    if (grid < 0) return;
    Args a{};
    for (int i = 0; i < 27; ++i) a.in[i] = (const float*)d_in[i];
    a.out = (float*)d_out; a.ws = (unsigned char*)d_ws;
    void* kargs[] = {&a};
    hipError_t e = hipLaunchCooperativeKernel((const void*)fwd_kernel, dim3(grid), dim3(512), kargs, LDS_BYTES, stream);
    if (e != hipSuccess) fprintf(stderr, "kernel_launch: cooperative launch failed: %s (grid %d)\n", hipGetErrorString(e), grid);
}
```

```cpp
#include <hip/hip_runtime.h>
#include <hip/hip_cooperative_groups.h>
#include <cstdio>
#include <cstdint>
namespace cg = cooperative_groups;

#define LAS __attribute__((address_space(3)))
typedef unsigned short bf16_t;
typedef short bf16x8 __attribute__((ext_vector_type(8)));
typedef short bf16x4 __attribute__((ext_vector_type(4)));
typedef float f32x4 __attribute__((ext_vector_type(4)));
typedef float f32x2 __attribute__((ext_vector_type(2)));
typedef float f32x16 __attribute__((ext_vector_type(16)));
typedef unsigned u32x4 __attribute__((ext_vector_type(4)));
typedef unsigned u32x2 __attribute__((ext_vector_type(2)));

#ifndef DBG_NO_MLSTM
#define DBG_NO_MLSTM 0
#endif
#ifndef DBG_WHICH
#define DBG_WHICH 7
#endif
#ifndef DBG_SELFTEST
#define DBG_SELFTEST 0
#endif
#ifndef DBG_REP_PH
#define DBG_REP_PH -1
#endif
#ifndef DBG_NO_ATTN
#define DBG_NO_ATTN 0
#endif

constexpr int SEQ = 2048, NB = 4, M = NB * SEQ, D = 2048, FF = 5632, NIN = 4096, DIN = 3912, NMOD = 18432;
constexpr float ALPHA = 1.189207115002721f;
constexpr float LN_EPS = 1e-5f;
constexpr float QSCALE = 0.07216878364870322f * 1.4426950408889634f;
constexpr int COL_CQ = 3080, COL_CKV = 3592, COL_KR = 3848;

constexpr size_t MiB = 1u << 20;
constexpr size_t WS_MOD = 1 * MiB, WS_ROPE = 2 * MiB, WS_GATES = 3 * MiB;
constexpr size_t WS_W13A = 4 * MiB, WS_W2A = 48 * MiB, WS_W13B = 70 * MiB, WS_W2B = 114 * MiB;
constexpr size_t WS_WIN = 136 * MiB, WS_WUQ = 152 * MiB, WS_WK = 154 * MiB, WS_WV = WS_WK + 524288, WS_WOUT = 156 * MiB;
constexpr size_t WS_U = 164 * MiB, WS_Z = 196 * MiB, WS_X = 260 * MiB, WS_R = 324 * MiB;
constexpr size_t WS_H = WS_R;
constexpr size_t WS_P = WS_R, WS_QA = WS_R + 64 * MiB, WS_KN = WS_R + 88 * MiB, WS_VT = WS_R + 104 * MiB, WS_HM = WS_R + 120 * MiB, WS_HRAW = WS_R + 152 * MiB;
constexpr size_t WS_QC = WS_R + 184 * MiB, WS_KC = WS_R + 192 * MiB, WS_VTM = WS_R + 200 * MiB, WS_EG = WS_R + 216 * MiB, WS_MG = WS_EG + 131072;
constexpr size_t WS_END = WS_R + 217 * MiB;

constexpr int LDS_BYTES = 147456;
constexpr int TAB_OFF = 131072 + 1024;

__device__ __forceinline__ unsigned cvt_pk_bf16(float lo, float hi) { unsigned r; asm volatile("v_cvt_pk_bf16_f32 %0, %1, %2" : "=v"(r) : "v"(lo), "v"(hi)); return r; }
__device__ __forceinline__ float bf2f(unsigned short b) { return __builtin_bit_cast(float, (unsigned)b << 16); }
__device__ __forceinline__ float bflo(unsigned w) { return __builtin_bit_cast(float, w << 16); }
__device__ __forceinline__ float bfhi(unsigned w) { return __builtin_bit_cast(float, w & 0xffff0000u); }
__device__ __forceinline__ float wave_sum(float v) {
#pragma unroll
    for (int o = 1; o < 64; o <<= 1) v += __shfl_xor(v, o);
    return v;
}
__device__ __forceinline__ float silu_f(float a) { return a * __builtin_amdgcn_rcpf(1.f + __expf(-a)); }
#define LDS_WAIT() asm volatile("s_waitcnt lgkmcnt(0)" ::: "memory")
__device__ __forceinline__ int opaque_tid() { int t = threadIdx.x; asm volatile("" : "+v"(t)); return t; }

namespace pg8 {
constexpr int BM = 256, BK = 64, HALF = 128, HTB = HALF * BK * 2, STAGE_BYTES = 8 * HTB, NXCD = 8, WGM = 8;
__host__ __device__ __forceinline__ int lds_byte(int r, int c) { const int st = (r >> 4) * 2 + (c >> 5), rr = r & 15, cc = c & 31, ob = rr * 64 + cc * 2; return st * 1024 + (ob ^ (((ob >> 9) & 1) << 5)); }
__host__ __device__ __forceinline__ void stage_rc(int b, int& R, int& C) { const int st = b / 1024, sb = b % 1024, swz = sb ^ (((sb >> 9) & 1) << 5); R = (st >> 1) * 16 + swz / 64; C = (st & 1) * 32 + (swz % 64) / 2; }
__host__ __device__ __forceinline__ int perm32(int rho) { const int n = rho >> 4, i = rho & 15; return 8 * (i >> 2) + 4 * n + (i & 3); }

struct Unit { int pm, pn; };
struct Gemm { const bf16_t* A; const bf16_t* Bt; int lda, ldb, K; };

struct StaticOrder {
    int nM, nN, nwg, G, c;
    __device__ void init(int Mr, int Nc, int G_, int c_) { nM = Mr / BM; nN = Nc / BM; nwg = nM * nN; G = G_; c = c_; }
    __device__ bool next(int i, Unit& u) const {
        const long L = (long)i * G + c; if (L >= nwg) return false;
        int wgid = (int)L; { const int q = nwg / NXCD, r = nwg % NXCD, xcd = wgid % NXCD, off = wgid / NXCD; wgid = (xcd < r ? xcd * (q + 1) : r * (q + 1) + (xcd - r) * q) + off; }
        const int nig = WGM * nN, gid = wgid / nig, fm = gid * WGM, gsz = (nM - fm) < WGM ? (nM - fm) : WGM;
        u.pm = fm + ((wgid % nig) % gsz); u.pn = (wgid % nig) / gsz; return true;
    }
};
struct SingleUnit { Unit u0; __device__ bool next(int i, Unit& u) const { if (i != 0) return false; u = u0; return true; } };

template <class Epi, class Sched, bool ALIGN_EPI>
__device__ __forceinline__ void gemm_phase(LAS unsigned char* lds, const Gemm g, const Sched& S, const Epi& E) {
    const int tid = opaque_tid(), wid = __builtin_amdgcn_readfirstlane(tid >> 6), lane = tid & 63, wr = wid >> 2, wc = wid & 3, fr = lane & 15, fq = lane >> 4;
    const int K = g.K, nt = K / BK;
    unsigned voffA[2], voffB[2];
#pragma unroll
    for (int i = 0; i < 2; ++i) { int R, C; stage_rc(tid * 16 + i * 8192, R, C); const int Rb = Epi::PERM ? ((R & ~31) + perm32(R & 31)) : R;
        voffA[i] = (unsigned)(R * g.lda + C) * 2u; voffB[i] = (unsigned)(Rb * g.ldb + C) * 2u; }
    const size_t kstep = (size_t)(BK * 2);
    const size_t hstepA = (size_t)HALF * g.lda * 2, hstepB = (size_t)HALF * g.ldb * 2;
    const size_t tstepA = 2 * hstepA, tstepB = 2 * hstepB;
    const unsigned ldsw = (unsigned)wid * 1024u;
    const int aoff = lds_byte(wr * 64 + fr, fq * 8), boff = lds_byte(wc * 32 + fr, fq * 8);
#define PG8_SA(b, h) (((b) * 2 + (h)) * HTB)
#define PG8_SB(b, h) ((4 + (b) * 2 + (h)) * HTB)
#define PG8_STAGE(bufoff, gbase, voff) do { _Pragma("unroll") for (int _i = 0; _i < 2; ++_i) \
        __builtin_amdgcn_global_load_lds((const unsigned*)((const char*)(gbase) + (voff)[_i]), (LAS unsigned*)(lds + (bufoff) + ldsw + _i * 8192), 16, 0, 0); } while (0)
#define PG8_LDA(dst, b, h) do { _Pragma("unroll") for (int m = 0; m < 4; ++m) _Pragma("unroll") for (int k = 0; k < 2; ++k) dst[m][k] = *(const LAS bf16x8*)(lds + PG8_SA(b, h) + aoff + m * 2048 + k * 1024); } while (0)
#define PG8_LDB(dst, b, h) do { _Pragma("unroll") for (int n = 0; n < 2; ++n) _Pragma("unroll") for (int k = 0; k < 2; ++k) dst[n][k] = *(const LAS bf16x8*)(lds + PG8_SB(b, h) + boff + n * 2048 + k * 1024); } while (0)
#define PG8_MMA(ai, bj, At, Bt) do { __builtin_amdgcn_s_setprio(1); _Pragma("unroll") for (int m = 0; m < 4; ++m) _Pragma("unroll") for (int n = 0; n < 2; ++n) _Pragma("unroll") for (int k = 0; k < 2; ++k) \
        acc[ai][bj][m][n] = __builtin_amdgcn_mfma_f32_16x16x32_bf16(Bt[n][k], At[m][k], acc[ai][bj][m][n], 0, 0, 0); __builtin_amdgcn_s_setprio(0); } while (0)
#define PG8_WAIT_V(n) asm volatile("s_waitcnt vmcnt(" #n ")" ::: "memory")
#define PG8_WAIT_L(n) asm volatile("s_waitcnt lgkmcnt(" #n ")" ::: "memory")
#define PG8_BAR __builtin_amdgcn_s_barrier()
#define PG8_SCHED __builtin_amdgcn_sched_barrier(0)
    Unit cur, nxt; int ui = 0;
    if (!S.next(0, cur)) return;
    f32x4 acc[2][2][4][2];
#pragma unroll
    for (int a = 0; a < 2; ++a)
#pragma unroll
        for (int b = 0; b < 2; ++b)
#pragma unroll
            for (int m = 0; m < 4; ++m)
#pragma unroll
                for (int n = 0; n < 2; ++n) acc[a][b][m][n] = (f32x4){0.f, 0.f, 0.f, 0.f};
    bf16x8 At[4][2], B0[2][2], B1[2][2];
    const char* cA = (const char*)g.A + (size_t)cur.pm * tstepA; const char* cB = (const char*)g.Bt + (size_t)cur.pn * tstepB;
    PG8_STAGE(PG8_SB(0, 0), cB, voffB); PG8_STAGE(PG8_SB(0, 1), cB + hstepB, voffB); PG8_STAGE(PG8_SA(0, 0), cA, voffA); PG8_STAGE(PG8_SA(0, 1), cA + hstepA, voffA);
    if (wr == 1) PG8_BAR;
    PG8_WAIT_V(2); PG8_BAR;
    PG8_STAGE(PG8_SB(1, 0), cB + kstep, voffB); PG8_STAGE(PG8_SA(1, 0), cA + kstep, voffA); PG8_STAGE(PG8_SB(1, 1), cB + hstepB + kstep, voffB);
    PG8_WAIT_V(6); PG8_BAR;
    for (;;) {
        const bool has_next = S.next(ui + 1, nxt);
        const char* nA = has_next ? (const char*)g.A + (size_t)nxt.pm * tstepA : cA; const char* nB = has_next ? (const char*)g.Bt + (size_t)nxt.pn * tstepB : cB;
        for (int t = 0; t < nt; t += 2) {
            const bool last = (t == nt - 2);
            const char* a1 = cA + (size_t)(t + 1) * kstep;
            const char* a2 = last ? nA : cA + (size_t)(t + 2) * kstep; const char* b2 = last ? nB : cB + (size_t)(t + 2) * kstep;
            const char* a3 = a2 + kstep; const char* b3 = b2 + kstep;
            PG8_LDB(B0, 0, 0); PG8_LDB(B1, 0, 1); PG8_SCHED; PG8_LDA(At, 0, 0); PG8_STAGE(PG8_SA(1, 1), a1 + hstepA, voffA);
            PG8_WAIT_V(8); PG8_WAIT_L(0); PG8_BAR; PG8_MMA(0, 0, At, B0); PG8_MMA(0, 1, At, B1); PG8_BAR; PG8_SCHED;
            PG8_LDA(At, 0, 1); PG8_STAGE(PG8_SB(0, 0), b2, voffB); PG8_STAGE(PG8_SB(0, 1), b2 + hstepB, voffB); PG8_STAGE(PG8_SA(0, 0), a2, voffA);
            PG8_WAIT_V(8); PG8_WAIT_L(0); PG8_BAR; PG8_MMA(1, 0, At, B0); PG8_MMA(1, 1, At, B1); PG8_BAR; PG8_SCHED;
            PG8_LDB(B0, 1, 0); PG8_LDB(B1, 1, 1); PG8_SCHED; PG8_LDA(At, 1, 0); PG8_STAGE(PG8_SA(0, 1), a2 + hstepA, voffA);
            PG8_WAIT_V(8); PG8_WAIT_L(0); PG8_BAR; PG8_MMA(0, 0, At, B0); PG8_MMA(0, 1, At, B1); PG8_BAR; PG8_SCHED;
            PG8_LDA(At, 1, 1); PG8_STAGE(PG8_SB(1, 0), b3, voffB); PG8_STAGE(PG8_SB(1, 1), b3 + hstepB, voffB); PG8_STAGE(PG8_SA(1, 0), a3, voffA);
            PG8_WAIT_V(8); PG8_WAIT_L(0); PG8_BAR; PG8_MMA(1, 0, At, B0); PG8_MMA(1, 1, At, B1); PG8_BAR; PG8_SCHED;
        }
        if constexpr (ALIGN_EPI) { if (wr == 0) PG8_BAR; }
        E(acc, cur, wr, wc, fr, fq);
        if (!has_next) break;
#pragma unroll
        for (int a = 0; a < 2; ++a)
#pragma unroll
            for (int b = 0; b < 2; ++b)
#pragma unroll
                for (int m = 0; m < 4; ++m)
#pragma unroll
                    for (int n = 0; n < 2; ++n) acc[a][b][m][n] = (f32x4){0.f, 0.f, 0.f, 0.f};
        cur = nxt; cA = nA; cB = nB; ++ui;
        if constexpr (ALIGN_EPI) { if (wr == 1) PG8_BAR; }
    }
    PG8_WAIT_V(0);
    if constexpr (!ALIGN_EPI) { if (wr == 0) PG8_BAR; }
    PG8_BAR;
#undef PG8_SA
#undef PG8_SB
#undef PG8_STAGE
#undef PG8_LDA
#undef PG8_LDB
#undef PG8_MMA
#undef PG8_WAIT_V
#undef PG8_WAIT_L
#undef PG8_BAR
#undef PG8_SCHED
}

typedef f32x4 Acc[2][2][4][2];

struct EpiSwiglu {
    static constexpr bool PERM = true;
    bf16_t* H;
    __device__ __forceinline__ void operator()(const Acc& acc, const Unit& u, int wr, int wc, int fr, int fq) const {
        const int row0 = u.pm * BM + wr * 64 + fr, col0 = u.pn * 128 + wc * 32 + 8 * fq;
#pragma unroll
        for (int ai = 0; ai < 2; ++ai)
#pragma unroll
            for (int m = 0; m < 4; ++m) {
                const f32x4 a0 = acc[ai][0][m][0], a1 = acc[ai][0][m][1], b0 = acc[ai][1][m][0], b1 = acc[ai][1][m][1];
                u32x4 w;
                w.x = cvt_pk_bf16(silu_f(a0[0]) * b0[0], silu_f(a0[1]) * b0[1]); w.y = cvt_pk_bf16(silu_f(a0[2]) * b0[2], silu_f(a0[3]) * b0[3]);
                w.z = cvt_pk_bf16(silu_f(a1[0]) * b1[0], silu_f(a1[1]) * b1[1]); w.w = cvt_pk_bf16(silu_f(a1[2]) * b1[2], silu_f(a1[3]) * b1[3]);
                *(u32x4*)(H + (size_t)(row0 + ai * HALF + m * 16) * FF + col0) = w;
            }
    }
};
struct EpiResid {
    static constexpr bool PERM = false;
    const float* X; float* Z; const float* gate; float coef;
    __device__ __forceinline__ void operator()(const Acc& acc, const Unit& u, int wr, int wc, int fr, int fq) const {
        const int row0 = u.pm * BM + wr * 64 + fr, b = u.pm >> 3, colb = u.pn * BM + wc * 32 + 4 * fq;
#pragma unroll
        for (int bj = 0; bj < 2; ++bj)
#pragma unroll
            for (int n = 0; n < 2; ++n) {
                const int col = colb + bj * HALF + n * 16;
                f32x4 gv = *(const f32x4*)(gate + (size_t)b * NMOD + col); gv = (gv + 1.0f) * coef;
#pragma unroll
                for (int ai = 0; ai < 2; ++ai)
#pragma unroll
                    for (int m = 0; m < 4; ++m) {
                        const size_t off = (size_t)(row0 + ai * HALF + m * 16) * D + col;
                        const f32x4 x = *(const f32x4*)(X + off);
                        *(f32x4*)(Z + off) = x * ALPHA + gv * acc[ai][bj][m][n];
                    }
            }
    }
};
__device__ __forceinline__ void rope8(f32x4& v0, f32x4& v1, const f32x2* cs) {
    const f32x2 c0 = cs[0], c1 = cs[1], c2 = cs[2], c3 = cs[3];
    float a, b;
    a = v0[0]; b = v0[1]; v0[0] = a * c0.x - b * c0.y; v0[1] = a * c0.y + b * c0.x;
    a = v0[2]; b = v0[3]; v0[2] = a * c1.x - b * c1.y; v0[3] = a * c1.y + b * c1.x;
    a = v1[0]; b = v1[1]; v1[0] = a * c2.x - b * c2.y; v1[1] = a * c2.y + b * c2.x;
    a = v1[2]; b = v1[3]; v1[2] = a * c3.x - b * c3.y; v1[3] = a * c3.y + b * c3.x;
}
struct EpiWin {
    static constexpr bool PERM = true;
    bf16_t* P; float* GATES; const f32x2* ROPE;
    __device__ __forceinline__ void operator()(const Acc& acc, const Unit& u, int wr, int wc, int fr, int fq) const {
        const int row0 = u.pm * BM + wr * 64 + fr, colb = u.pn * BM + wc * 32 + 8 * fq;
#pragma unroll
        for (int bj = 0; bj < 2; ++bj) {
            const int col = colb + bj * HALF;
            const bool isg = (col == 3072), isr = (col >= COL_KR && col < COL_KR + 64);
#pragma unroll
            for (int ai = 0; ai < 2; ++ai)
#pragma unroll
                for (int m = 0; m < 4; ++m) {
                    const int row = row0 + ai * HALF + m * 16;
                    f32x4 v0 = acc[ai][bj][m][0], v1 = acc[ai][bj][m][1];
                    if (isg) { *(f32x4*)(GATES + (size_t)row * 8) = v0; *(f32x4*)(GATES + (size_t)row * 8 + 4) = v1; }
                    if (isr) rope8(v0, v1, ROPE + (size_t)(row & (SEQ - 1)) * 32 + ((col - COL_KR) >> 1));
                    u32x4 w; w.x = cvt_pk_bf16(v0[0], v0[1]); w.y = cvt_pk_bf16(v0[2], v0[3]); w.z = cvt_pk_bf16(v1[0], v1[1]); w.w = cvt_pk_bf16(v1[2], v1[3]);
                    *(u32x4*)(P + (size_t)row * NIN + col) = w;
                }
        }
    }
};
struct EpiLR {
    static constexpr bool PERM = true;
    int mode; bf16_t* O; int ldo; const LAS float* tab; const f32x2* ROPE;
    __device__ __forceinline__ void operator()(const Acc& acc, const Unit& u, int wr, int wc, int fr, int fq) const {
#pragma unroll
        for (int bj = 0; bj < 2; ++bj) {
            const int lcol = wc * 32 + 8 * fq + bj * HALF, col = u.pn * BM + lcol;
            f32x4 c0 = {1.f, 1.f, 1.f, 1.f}, c1 = c0;
            if (mode == 2) { c0 = *(const LAS f32x4*)(tab + lcol); c1 = *(const LAS f32x4*)(tab + lcol + 4); }
            const int within = col % 192;
            const bool isr = (mode == 0) && (within >= 128);
#pragma unroll
            for (int ai = 0; ai < 2; ++ai)
#pragma unroll
                for (int m = 0; m < 4; ++m) {
                    const int lrow = wr * 64 + fr + ai * HALF + m * 16, row = u.pm * BM + lrow;
                    f32x4 v0 = acc[ai][bj][m][0] * c0, v1 = acc[ai][bj][m][1] * c1;
                    if (mode != 2) { float r = tab[lrow]; if (mode == 0) r *= QSCALE; v0 = v0 * r; v1 = v1 * r; }
                    if (isr) rope8(v0, v1, ROPE + (size_t)(row & (SEQ - 1)) * 32 + ((within - 128) >> 1));
                    u32x4 w; w.x = cvt_pk_bf16(v0[0], v0[1]); w.y = cvt_pk_bf16(v0[2], v0[3]); w.z = cvt_pk_bf16(v1[0], v1[1]); w.w = cvt_pk_bf16(v1[2], v1[3]);
                    *(u32x4*)(O + (size_t)row * ldo + col) = w;
                }
        }
    }
};
}

__device__ __forceinline__ int map_row(int kind, int n) {
    switch (kind) {
        case 0: return (n >> 7) * 256 + (n & 127);
        case 1: return (n >> 7) * 256 + 128 + (n & 127);
        case 3: { if (n < COL_KR) return n; const int j = n - COL_KR; return COL_KR + ((j < 32) ? 2 * j : 2 * (j - 32) + 1); }
        case 4: { const int h = n / 192, r = n - h * 192; if (r < 128) return n; const int j = r - 128; return h * 192 + 128 + ((j < 32) ? 2 * j : 2 * (j - 32) + 1); }
        case 5: { const int h = n >> 8, r = n & 255; return (r < 128) ? h * 128 + r : 1024 + h * 128 + (r - 128); }
        default: return n;
    }
}
constexpr int TR_LD = 68, TR_BYTES = 64 * TR_LD * 4;
__device__ __forceinline__ void tr_item(const float* W, int K, int N, bf16_t* WT, int kind, const float* gk, LAS float* scr, int item, int lane) {
    const int nblk = (N + 63) >> 6, kb = item / nblk, nb = item - kb * nblk, k0 = 64 * kb, n0 = 64 * nb;
    const int nn = n0 + 4 * (lane & 15); const bool ok = nn < N;
    f32x4 v[16];
#pragma unroll
    for (int i = 0; i < 16; ++i) { const int kk = 4 * i + (lane >> 4); v[i] = ok ? *(const f32x4*)(W + (size_t)(k0 + kk) * N + nn) : (f32x4){0.f, 0.f, 0.f, 0.f}; }
#pragma unroll
    for (int i = 0; i < 16; ++i) { const int kk = 4 * i + (lane >> 4); f32x4 x = v[i]; if (gk) x = x * gk[k0 + kk]; *(LAS f32x4*)(scr + kk * TR_LD + 4 * (lane & 15)) = x; }
    LDS_WAIT(); asm volatile("" ::: "memory");
    if (n0 + lane < N) {
        bf16_t* dst = WT + (size_t)map_row(kind, n0 + lane) * K + k0;
#pragma unroll
        for (int c = 0; c < 8; ++c) { const LAS float* sp = scr + (8 * c) * TR_LD + lane;
            u32x4 o; o.x = cvt_pk_bf16(sp[0 * TR_LD], sp[1 * TR_LD]); o.y = cvt_pk_bf16(sp[2 * TR_LD], sp[3 * TR_LD]); o.z = cvt_pk_bf16(sp[4 * TR_LD], sp[5 * TR_LD]); o.w = cvt_pk_bf16(sp[6 * TR_LD], sp[7 * TR_LD]);
            *(u32x4*)(dst + 8 * c) = o; }
    }
    LDS_WAIT(); asm volatile("" ::: "memory");
}

struct Args { const float* in[27]; float* out; unsigned char* ws; };

constexpr int AK_STRIDE = 400, AV_STRIDE = 144, AK_BUF = 64 * AK_STRIDE, AV_BUF = 128 * AV_STRIDE, AV_OFF = 2 * AK_BUF;
__device__ __forceinline__ void attn_unit(const bf16_t* QA, const bf16_t* KN, const bf16_t* P, const bf16_t* VT, bf16_t* HM, int b, int h, int qb, LAS unsigned char* lds, int tid, int wave, int lane) {
    const int tok0 = b * SEQ, q0 = qb * 256 + wave * 32, ql = lane & 31, hh = lane >> 5;
    bf16x8 qf[12];
    { const bf16_t* qp = QA + (size_t)(tok0 + q0 + ql) * 1536 + h * 192 + 8 * hh;
#pragma unroll
      for (int kb = 0; kb < 12; ++kb) qf[kb] = *(const bf16x8*)(qp + 16 * kb); }
    f32x16 o[4];
#pragma unroll
    for (int e = 0; e < 4; ++e)
#pragma unroll
        for (int r = 0; r < 16; ++r) o[e][r] = 0.f;
    float mrun = -1e30f, lrun = 0.f;
    const int ntiles = 4 * (qb + 1);
    const bf16_t* KNb = KN + (size_t)tok0 * 1024 + h * 128; const bf16_t* KRb = P + (size_t)tok0 * NIN + COL_KR; const bf16_t* VTb = VT + (size_t)(h * 128) * M + tok0;
    int ksrc[3], kdst[3], vsrc[2], vdst[2];
#pragma unroll
    for (int i = 0; i < 2; ++i) { const int c = tid + 512 * i, key = c >> 4, cc = c & 15; ksrc[i] = key * 1024 + 8 * cc; kdst[i] = key * AK_STRIDE + cc * 16; }
    { const int key = tid >> 3, cc = tid & 7; ksrc[2] = key * NIN + 8 * cc; kdst[2] = key * AK_STRIDE + (16 + cc) * 16; }
#pragma unroll
    for (int i = 0; i < 2; ++i) { const int c = tid + 512 * i, e = c >> 3, cc = c & 7; vsrc[i] = e * M + 8 * cc; vdst[i] = AV_OFF + e * AV_STRIDE + cc * 16; }
    u32x4 kr[3], vr[2];
#pragma unroll
    for (int i = 0; i < 3; ++i) kr[i] = *(const u32x4*)((i < 2 ? KNb : KRb) + ksrc[i]);
#pragma unroll
    for (int i = 0; i < 2; ++i) vr[i] = *(const u32x4*)(VTb + vsrc[i]);
#pragma unroll
    for (int i = 0; i < 3; ++i) *(LAS u32x4*)(lds + kdst[i]) = kr[i];
#pragma unroll
    for (int i = 0; i < 2; ++i) *(LAS u32x4*)(lds + vdst[i]) = vr[i];
    __syncthreads();
    for (int kt = 0; kt < ntiles; ++kt) {
        const int cur = kt & 1;
        const bool more = (kt + 1 < ntiles);
        if (more) {
#pragma unroll
            for (int i = 0; i < 3; ++i) kr[i] = *(const u32x4*)((i < 2 ? KNb + (size_t)(kt + 1) * 65536 : KRb + (size_t)(kt + 1) * (64 * NIN)) + ksrc[i]);
#pragma unroll
            for (int i = 0; i < 2; ++i) vr[i] = *(const u32x4*)(VTb + (kt + 1) * 64 + vsrc[i]);
        }
        if (kt * 64 <= q0 + 31) {
            const LAS unsigned char* kb_ = lds + cur * AK_BUF;
            const LAS unsigned char* vb_ = lds + AV_OFF + cur * AV_BUF;
            f32x16 st[2];
#pragma unroll
            for (int t = 0; t < 2; ++t) {
#pragma unroll
                for (int r = 0; r < 16; ++r) st[t][r] = 0.f;
#pragma unroll
                for (int kb = 0; kb < 12; ++kb) {
                    const bf16x8 a = *(const LAS bf16x8*)(kb_ + (32 * t + ql) * AK_STRIDE + (16 * kb + 8 * hh) * 2);
                    st[t] = __builtin_amdgcn_mfma_f32_32x32x16_bf16(a, qf[kb], st[t], 0, 0, 0);
                }
            }
            if (kt * 64 + 63 > q0) {
                const int qpos = q0 + ql;
#pragma unroll
                for (int t = 0; t < 2; ++t)
#pragma unroll
                    for (int r = 0; r < 16; ++r) { const int key = kt * 64 + 32 * t + (r & 3) + 8 * (r >> 2) + 4 * hh; if (key > qpos) st[t][r] = -1e30f; }
            }
            float mx = -1e30f;
#pragma unroll
            for (int t = 0; t < 2; ++t)
#pragma unroll
                for (int r = 0; r < 16; ++r) mx = fmaxf(mx, st[t][r]);
            mx = fmaxf(mx, __shfl_xor(mx, 32));
            const float mnew = fmaxf(mrun, mx), alpha = __builtin_amdgcn_exp2f(mrun - mnew);
            float rs = 0.f;
#pragma unroll
            for (int t = 0; t < 2; ++t)
#pragma unroll
                for (int r = 0; r < 16; ++r) { const float p = __builtin_amdgcn_exp2f(st[t][r] - mnew); st[t][r] = p; rs += p; }
            rs += __shfl_xor(rs, 32);
            lrun = lrun * alpha + rs; mrun = mnew;
#pragma unroll
            for (int e = 0; e < 4; ++e)
#pragma unroll
                for (int r = 0; r < 16; ++r) o[e][r] *= alpha;
#pragma unroll
            for (int t = 0; t < 2; ++t) {
                bf16x8 pb[2];
#pragma unroll
                for (int kb = 0; kb < 2; ++kb) {
                    u32x4 w;
                    w.x = cvt_pk_bf16(st[t][8 * kb + 0], st[t][8 * kb + 1]); w.y = cvt_pk_bf16(st[t][8 * kb + 2], st[t][8 * kb + 3]);
                    w.z = cvt_pk_bf16(st[t][8 * kb + 4], st[t][8 * kb + 5]); w.w = cvt_pk_bf16(st[t][8 * kb + 6], st[t][8 * kb + 7]);
                    pb[kb] = __builtin_bit_cast(bf16x8, w);
                }
#pragma unroll
                for (int e = 0; e < 4; ++e)
#pragma unroll
                    for (int kb = 0; kb < 2; ++kb) {
                        const LAS unsigned char* vp = vb_ + (32 * e + ql) * AV_STRIDE + (16 * (2 * t + kb) + 4 * hh) * 2;
                        const u32x2 lo = *(const LAS u32x2*)vp, hi = *(const LAS u32x2*)(vp + 16);
                        const u32x4 av = {lo.x, lo.y, hi.x, hi.y};
                        o[e] = __builtin_amdgcn_mfma_f32_32x32x16_bf16(__builtin_bit_cast(bf16x8, av), pb[kb], o[e], 0, 0, 0);
                    }
            }
        }
        if (more) {
            LAS unsigned char* kw = lds + (cur ^ 1) * AK_BUF; LAS unsigned char* vw = lds + (cur ^ 1) * AV_BUF;
#pragma unroll
            for (int i = 0; i < 3; ++i) *(LAS u32x4*)(kw + kdst[i]) = kr[i];
#pragma unroll
            for (int i = 0; i < 2; ++i) *(LAS u32x4*)(vw + vdst[i]) = vr[i];
        }
        __syncthreads();
    }
    const float inv = 1.0f / lrun;
    bf16_t* op = HM + (size_t)(tok0 + q0 + ql) * D + 1024 + h * 128 + 4 * hh;
#pragma unroll
    for (int e = 0; e < 4; ++e)
#pragma unroll
        for (int g = 0; g < 4; ++g) {
            u32x2 w; w.x = cvt_pk_bf16(o[e][4 * g + 0] * inv, o[e][4 * g + 1] * inv); w.y = cvt_pk_bf16(o[e][4 * g + 2] * inv, o[e][4 * g + 3] * inv);
            *(u32x2*)(op + 32 * e + 8 * g) = w;
        }
}

constexpr int MK_STRIDE = 272, MK_BUF = 64 * MK_STRIDE, MV_OFF = 2 * MK_BUF, ME_OFF = MV_OFF + 2 * AV_BUF;
__device__ __forceinline__ void mlp_unit(const bf16_t* QC, const bf16_t* KC, const bf16_t* VTM, const float* EG, const float* MG, float* HRAW, int b, int h, int qb, int eh, LAS unsigned char* lds, int tid, int wave, int lane) {
    const int tok0 = b * SEQ, q0 = qb * 256 + wave * 32, ql = lane & 31, hh = lane >> 5, bh = b * 4 + h;
    bf16x8 qf[8];
    { const bf16_t* qp = QC + (size_t)(tok0 + q0 + ql) * 512 + h * 128 + 8 * hh;
#pragma unroll
      for (int kb = 0; kb < 8; ++kb) qf[kb] = *(const bf16x8*)(qp + 16 * kb); }
    const float mg = MG[bh * SEQ + q0 + ql];
    f32x16 o[4];
#pragma unroll
    for (int e = 0; e < 4; ++e)
#pragma unroll
        for (int r = 0; r < 16; ++r) o[e][r] = 0.f;
    const int ntiles = 4 * (qb + 1);
    const bf16_t* KCb = KC + (size_t)tok0 * 512 + h * 128; const bf16_t* VTb = VTM + (size_t)(h * 256 + eh * 128) * M + tok0; const float* EGb = EG + bh * SEQ;
    int ksrc[2], kdst[2], vsrc[2], vdst[2];
#pragma unroll
    for (int i = 0; i < 2; ++i) { const int c = tid + 512 * i, key = c >> 4, cc = c & 15; ksrc[i] = key * 512 + 8 * cc; kdst[i] = key * MK_STRIDE + cc * 16; }
#pragma unroll
    for (int i = 0; i < 2; ++i) { const int c = tid + 512 * i, e = c >> 3, cc = c & 7; vsrc[i] = e * M + 8 * cc; vdst[i] = MV_OFF + e * AV_STRIDE + cc * 16; }
    u32x4 kr[2], vr[2]; float er = 0.f;
#pragma unroll
    for (int i = 0; i < 2; ++i) kr[i] = *(const u32x4*)(KCb + ksrc[i]);
#pragma unroll
    for (int i = 0; i < 2; ++i) vr[i] = *(const u32x4*)(VTb + vsrc[i]);
    if (tid < 64) er = EGb[tid];
#pragma unroll
    for (int i = 0; i < 2; ++i) *(LAS u32x4*)(lds + kdst[i]) = kr[i];
#pragma unroll
    for (int i = 0; i < 2; ++i) *(LAS u32x4*)(lds + vdst[i]) = vr[i];
    if (tid < 64) *(LAS float*)(lds + ME_OFF + 4 * tid) = er;
    __syncthreads();
    for (int kt = 0; kt < ntiles; ++kt) {
        const int cur = kt & 1;
        const bool more = (kt + 1 < ntiles);
        if (more) {
#pragma unroll
            for (int i = 0; i < 2; ++i) kr[i] = *(const u32x4*)(KCb + (size_t)(kt + 1) * (64 * 512) + ksrc[i]);
#pragma unroll
            for (int i = 0; i < 2; ++i) vr[i] = *(const u32x4*)(VTb + (kt + 1) * 64 + vsrc[i]);
            if (tid < 64) er = EGb[(kt + 1) * 64 + tid];
        }
        if (kt * 64 <= q0 + 31) {
            const LAS unsigned char* kb_ = lds + cur * MK_BUF;
            const LAS unsigned char* vb_ = lds + MV_OFF + cur * AV_BUF;
            const LAS unsigned char* eb_ = lds + ME_OFF + cur * 256;
            const int qpos = q0 + ql;
#pragma unroll
            for (int t = 0; t < 2; ++t) {
                f32x16 st;
#pragma unroll
                for (int r = 0; r < 16; ++r) st[r] = 0.f;
#pragma unroll
                for (int kb = 0; kb < 8; ++kb) {
                    const bf16x8 a = *(const LAS bf16x8*)(kb_ + (32 * t + ql) * MK_STRIDE + (16 * kb + 8 * hh) * 2);
                    st = __builtin_amdgcn_mfma_f32_32x32x16_bf16(a, qf[kb], st, 0, 0, 0);
                }
#pragma unroll
                for (int g = 0; g < 4; ++g) {
                    const f32x4 ev = *(const LAS f32x4*)(eb_ + 4 * (32 * t + 8 * g + 4 * hh));
#pragma unroll
                    for (int i = 0; i < 4; ++i) {
                        const int key = kt * 64 + 32 * t + 8 * g + 4 * hh + i;
                        const float w = __builtin_amdgcn_exp2f(fminf(ev[i] - mg, 0.f));
                        st[4 * g + i] = (key <= qpos) ? st[4 * g + i] * w : 0.f;
                    }
                }
                bf16x8 pb[2];
#pragma unroll
                for (int kb = 0; kb < 2; ++kb) {
                    u32x4 w;
                    w.x = cvt_pk_bf16(st[8 * kb + 0], st[8 * kb + 1]); w.y = cvt_pk_bf16(st[8 * kb + 2], st[8 * kb + 3]);
                    w.z = cvt_pk_bf16(st[8 * kb + 4], st[8 * kb + 5]); w.w = cvt_pk_bf16(st[8 * kb + 6], st[8 * kb + 7]);
                    pb[kb] = __builtin_bit_cast(bf16x8, w);
                }
#pragma unroll
                for (int e = 0; e < 4; ++e)
#pragma unroll
                    for (int kb = 0; kb < 2; ++kb) {
                        const LAS unsigned char* vp = vb_ + (32 * e + ql) * AV_STRIDE + (16 * (2 * t + kb) + 4 * hh) * 2;
                        const u32x2 lo = *(const LAS u32x2*)vp, hi = *(const LAS u32x2*)(vp + 16);
                        const u32x4 av = {lo.x, lo.y, hi.x, hi.y};
                        o[e] = __builtin_amdgcn_mfma_f32_32x32x16_bf16(__builtin_bit_cast(bf16x8, av), pb[kb], o[e], 0, 0, 0);
                    }
            }
        }
        if (more) {
            LAS unsigned char* kw = lds + (cur ^ 1) * MK_BUF; LAS unsigned char* vw = lds + (cur ^ 1) * AV_BUF;
#pragma unroll
            for (int i = 0; i < 2; ++i) *(LAS u32x4*)(kw + kdst[i]) = kr[i];
#pragma unroll
            for (int i = 0; i < 2; ++i) *(LAS u32x4*)(vw + vdst[i]) = vr[i];
            if (tid < 64) *(LAS float*)(lds + ME_OFF + (cur ^ 1) * 256 + 4 * tid) = er;
        }
        __syncthreads();
    }
    float* op = HRAW + (size_t)(tok0 + q0 + ql) * 1024 + h * 256 + eh * 128 + 4 * hh;
#pragma unroll
    for (int e = 0; e < 4; ++e)
#pragma unroll
        for (int g = 0; g < 4; ++g) {
            const f32x4 w = {o[e][4 * g + 0], o[e][4 * g + 1], o[e][4 * g + 2], o[e][4 * g + 3]};
            *(f32x4*)(op + 32 * e + 8 * g) = w;
        }
}

__global__ void __launch_bounds__(512, 2) fwd_kernel(Args args) {
    extern __shared__ __attribute__((aligned(16))) unsigned char lds_raw[];
    LAS unsigned char* lds = (LAS unsigned char*)lds_raw;
    cg::grid_group grid = cg::this_grid();
    const int G = gridDim.x, bid = blockIdx.x, NGW = G * 8;
#define GRID_SYNC() do { asm volatile("s_waitcnt vmcnt(0)" ::: "memory"); __syncthreads(); grid.sync(); } while (0)
#define PH_THREAD() const int tid = opaque_tid(), lane = tid & 63, wave = __builtin_amdgcn_readfirstlane(tid >> 6), gw = bid * 8 + wave; (void)lane; (void)gw; (void)tid
    unsigned char* ws = args.ws;
    const float* x_in = args.in[0];
    float* MOD = (float*)(ws + WS_MOD); f32x2* ROPE = (f32x2*)(ws + WS_ROPE); float* GATES = (float*)(ws + WS_GATES);
    bf16_t* U = (bf16_t*)(ws + WS_U); float* Z = (float*)(ws + WS_Z); float* X = (float*)(ws + WS_X);
    bf16_t* Hb = (bf16_t*)(ws + WS_H); bf16_t* P = (bf16_t*)(ws + WS_P); bf16_t* QA = (bf16_t*)(ws + WS_QA); bf16_t* KN = (bf16_t*)(ws + WS_KN);
    bf16_t* VT = (bf16_t*)(ws + WS_VT); bf16_t* HM = (bf16_t*)(ws + WS_HM); float* HRAW = (float*)(ws + WS_HRAW);
    bf16_t* QC = (bf16_t*)(ws + WS_QC); bf16_t* KC = (bf16_t*)(ws + WS_KC); bf16_t* VTM = (bf16_t*)(ws + WS_VTM); float* EG = (float*)(ws + WS_EG); float* MG = (float*)(ws + WS_MG);

    for (int rep_ = 0; rep_ < ((0 == DBG_REP_PH) ? 2 : 1); ++rep_) { constexpr int ph = 0; PH_THREAD(); if (rep_) { asm volatile("s_waitcnt vmcnt(0)" ::: "memory"); __syncthreads(); }
            if (bid < 144) {
                LAS float* sc = (LAS float*)lds; LAS float* red = sc + 8192;
                const float* c = args.in[1]; const float* w_ada = args.in[2]; const float* b_ada = args.in[3];
                for (int i = tid; i < 8192; i += 512) { const float v = c[i]; sc[i] = v / (1.f + expf(-v)); }
                __syncthreads();
                const int col = bid * 128 + 2 * lane;
                float a[4][2];
#pragma unroll
                for (int b = 0; b < 4; ++b) { a[b][0] = 0.f; a[b][1] = 0.f; }
                const float* wp = w_ada + (size_t)(256 * wave) * NMOD + col;
#pragma unroll 16
                for (int k = 0; k < 256; ++k) {
                    const f32x2 v = *(const f32x2*)(wp + (size_t)k * NMOD);
#pragma unroll
                    for (int b = 0; b < 4; ++b) { const float s = sc[b * 2048 + 256 * wave + k]; a[b][0] += s * v.x; a[b][1] += s * v.y; }
                }
#pragma unroll
                for (int b = 0; b < 4; ++b) { red[(wave * 4 + b) * 128 + 2 * lane] = a[b][0]; red[(wave * 4 + b) * 128 + 2 * lane + 1] = a[b][1]; }
                __syncthreads();
                { const int b = tid >> 7, cc = tid & 127; float s = b_ada[bid * 128 + cc];
#pragma unroll
                  for (int w = 0; w < 8; ++w) s += red[(w * 4 + b) * 128 + cc];
                  MOD[(size_t)b * NMOD + bid * 128 + cc] = s; }
                __syncthreads();
            }
            for (int i = bid * 512 + tid; i < SEQ * 32; i += G * 512) {
                const int s = i >> 5, j = i & 31;
                const float inv = (float)pow(10000.0, -(double)j / 32.0);
                const float ang = (float)s * inv;
                const double rev = (double)ang * 0.15915494309189535; const float fr_ = (float)(rev - rint(rev));
                ROPE[i] = (f32x2){__builtin_amdgcn_cosf(fr_), __builtin_amdgcn_sinf(fr_)};
            }
            __syncthreads();
            LAS float* scr = (LAS float*)(lds + wave * TR_BYTES);
            constexpr int I_UP = 32 * 88, I_DN = 88 * 32, I_IN = 32 * 62, I_UQ = 8 * 24, I_KV = 4 * 32, I_WO = 32 * 32;
            constexpr int NIT = 4 * I_UP + 2 * I_DN + I_IN + I_UQ + I_KV + I_WO;
            static_assert(NIT == 1152 * 9 + 896 * 11, "item split between adaLN blocks and the rest");
            int it0, itn, its;
            if (G == 256) { if (bid < 144) { it0 = gw; its = 1152; itn = 1152 * 9; } else { it0 = 1152 * 9 + (gw - 1152); its = 896; itn = NIT; } }
            else { it0 = gw; its = NGW; itn = NIT; }
            for (int it = it0; it < itn; it += its) {
                int r = it;
                if (r < I_UP) { tr_item(args.in[4], D, FF, (bf16_t*)(ws + WS_W13A), 0, nullptr, scr, r, lane); continue; } r -= I_UP;
                if (r < I_UP) { tr_item(args.in[5], D, FF, (bf16_t*)(ws + WS_W13A), 1, nullptr, scr, r, lane); continue; } r -= I_UP;
                if (r < I_DN) { tr_item(args.in[6], FF, D, (bf16_t*)(ws + WS_W2A), 2, nullptr, scr, r, lane); continue; } r -= I_DN;
                if (r < I_IN) { tr_item(args.in[9], D, DIN, (bf16_t*)(ws + WS_WIN), 3, nullptr, scr, r, lane); continue; } r -= I_IN;
                if (r < I_UQ) { tr_item(args.in[16], 512, 1536, (bf16_t*)(ws + WS_WUQ), 4, args.in[15], scr, r, lane); continue; } r -= I_UQ;
                if (r < I_KV) { tr_item(args.in[18], 256, 2048, (bf16_t*)(ws + WS_WK), 5, args.in[17], scr, r, lane); continue; } r -= I_KV;
                if (r < I_WO) { tr_item(args.in[19], D, D, (bf16_t*)(ws + WS_WOUT), 2, nullptr, scr, r, lane); continue; } r -= I_WO;
                if (r < I_UP) { tr_item(args.in[22], D, FF, (bf16_t*)(ws + WS_W13B), 0, nullptr, scr, r, lane); continue; } r -= I_UP;
                if (r < I_UP) { tr_item(args.in[23], D, FF, (bf16_t*)(ws + WS_W13B), 1, nullptr, scr, r, lane); continue; } r -= I_UP;
                tr_item(args.in[24], FF, D, (bf16_t*)(ws + WS_W2B), 2, nullptr, scr, r, lane);
            }
    }
    GRID_SYNC();
    for (int rep_ = 0; rep_ < ((1 == DBG_REP_PH) ? 2 : 1); ++rep_) { constexpr int ph = 1; PH_THREAD(); if (rep_) { asm volatile("s_waitcnt vmcnt(0)" ::: "memory"); __syncthreads(); }
            for (int row = gw; row < M; row += NGW) {
                const int b = row >> 11; const float* mb = MOD + (size_t)b * NMOD;
                const f32x4* xr = (const f32x4*)(x_in + (size_t)row * D) + lane; u32x2* ur = (u32x2*)(U + (size_t)row * D) + lane;
#pragma unroll
                for (int j = 0; j < 8; ++j) { const f32x4 v = xr[64 * j]; const f32x4 sh = *((const f32x4*)mb + lane + 64 * j), scl = *((const f32x4*)(mb + 2048) + lane + 64 * j);
                    const f32x4 y = v * (scl + 1.0f) + sh; u32x2 w; w.x = cvt_pk_bf16(y[0], y[1]); w.y = cvt_pk_bf16(y[2], y[3]); ur[64 * j] = w; }
            }
            }
    GRID_SYNC();
    for (int rep_ = 0; rep_ < ((2 == DBG_REP_PH) ? 2 : 1); ++rep_) { constexpr int ph = 2; PH_THREAD(); if (rep_) { asm volatile("s_waitcnt vmcnt(0)" ::: "memory"); __syncthreads(); }
            const bf16_t* Wt = (const bf16_t*)(ws + (ph == 2 ? WS_W13A : WS_W13B));
            pg8::Gemm g{U, Wt, D, D, D}; pg8::StaticOrder S; S.init(M, 2 * FF, G, bid);
            pg8::EpiSwiglu E{Hb};
            pg8::gemm_phase<pg8::EpiSwiglu, pg8::StaticOrder, true>(lds, g, S, E);
            }
    GRID_SYNC();
    for (int rep_ = 0; rep_ < ((3 == DBG_REP_PH) ? 2 : 1); ++rep_) { constexpr int ph = 3; PH_THREAD(); if (rep_) { asm volatile("s_waitcnt vmcnt(0)" ::: "memory"); __syncthreads(); }
            const int s = (ph == 3) ? 0 : (ph == 9 ? 1 : 2);
            const bf16_t* A = (ph == 9) ? HM : Hb; const bf16_t* Wt = (const bf16_t*)(ws + (ph == 3 ? WS_W2A : (ph == 9 ? WS_WOUT : WS_W2B)));
            const int K = (ph == 9) ? D : FF;
            const float* Xr = (ph == 3) ? x_in : X;
            pg8::Gemm g{A, Wt, K, K, K}; pg8::StaticOrder S; S.init(M, D, G, bid);
            pg8::EpiResid E{Xr, Z, MOD + s * 6144 + 4096, (ph == 9) ? 1.0f : 0.5f};
            pg8::gemm_phase<pg8::EpiResid, pg8::StaticOrder, true>(lds, g, S, E);
            }
    GRID_SYNC();
    for (int rep_ = 0; rep_ < ((4 == DBG_REP_PH) ? 2 : 1); ++rep_) { constexpr int ph = 4; PH_THREAD(); if (rep_) { asm volatile("s_waitcnt vmcnt(0)" ::: "memory"); __syncthreads(); }
            const int s = (ph == 4) ? 1 : 2;
            const float* gp = args.in[ph == 4 ? 7 : (ph == 10 ? 20 : 25)]; const float* bp = args.in[ph == 4 ? 8 : (ph == 10 ? 21 : 26)];
            float* Xo = (ph == 13) ? args.out : X;
            for (int row = gw; row < M; row += NGW) {
                const int b = row >> 11; const float* mb = MOD + (size_t)b * NMOD + s * 6144;
                const f32x4* zr = (const f32x4*)(Z + (size_t)row * D) + lane;
                f32x4 v[8]; float sm = 0.f;
#pragma unroll
                for (int j = 0; j < 8; ++j) { v[j] = zr[64 * j]; sm += (v[j][0] + v[j][1]) + (v[j][2] + v[j][3]); }
                const float mean = wave_sum(sm) * (1.f / D); float s2 = 0.f;
#pragma unroll
                for (int j = 0; j < 8; ++j) { v[j] = v[j] - mean; s2 += (v[j][0] * v[j][0] + v[j][1] * v[j][1]) + (v[j][2] * v[j][2] + v[j][3] * v[j][3]); }
                const float rstd = 1.f / sqrtf(wave_sum(s2) * (1.f / D) + LN_EPS);
                f32x4* xo = (f32x4*)(Xo + (size_t)row * D) + lane; u32x2* ur = (u32x2*)(U + (size_t)row * D) + lane;
#pragma unroll
                for (int j = 0; j < 8; ++j) {
                    const f32x4 gg = *((const f32x4*)gp + lane + 64 * j), bb = *((const f32x4*)bp + lane + 64 * j);
                    const f32x4 y = v[j] * rstd * gg + bb; xo[64 * j] = y;
                    if (ph != 13) { const f32x4 sh = *((const f32x4*)mb + lane + 64 * j), scl = *((const f32x4*)(mb + 2048) + lane + 64 * j);
                        const f32x4 uu = y * (scl + 1.0f) + sh; u32x2 w; w.x = cvt_pk_bf16(uu[0], uu[1]); w.y = cvt_pk_bf16(uu[2], uu[3]); ur[64 * j] = w; }
                }
            }
            }
    GRID_SYNC();
    for (int rep_ = 0; rep_ < ((5 == DBG_REP_PH) ? 2 : 1); ++rep_) { constexpr int ph = 5; PH_THREAD(); if (rep_) { asm volatile("s_waitcnt vmcnt(0)" ::: "memory"); __syncthreads(); }
            pg8::Gemm g{U, (const bf16_t*)(ws + WS_WIN), D, D, D}; pg8::StaticOrder S; S.init(M, NIN, G, bid);
            pg8::EpiWin E{P, GATES, ROPE};
            pg8::gemm_phase<pg8::EpiWin, pg8::StaticOrder, true>(lds, g, S, E);
            }
    GRID_SYNC();
    for (int rep_ = 0; rep_ < ((6 == DBG_REP_PH) ? 2 : 1); ++rep_) { constexpr int ph = 6; PH_THREAD(); if (rep_) { asm volatile("s_waitcnt vmcnt(0)" ::: "memory"); __syncthreads(); }
            LAS float* tab = (LAS float*)(lds + TAB_OFF);
            for (int L = bid; L < 448; L += G) {
                int mode, pm, pn;
                if (L < 192) { mode = 0; pm = L / 6; pn = L % 6; } else if (L < 320) { mode = 1; pm = (L - 192) >> 2; pn = (L - 192) & 3; } else { mode = 2; pm = (L - 320) & 3; pn = (L - 320) >> 2; }
                const int t0 = ((mode == 2) ? pn : pm) * 256;
                __syncthreads();
                for (int r = 0; r < 32; ++r) {
                    const bf16_t* pr = P + (size_t)(t0 + 32 * wave + r) * NIN; float ss;
                    if (mode == 0) { const u32x4 w = *(const u32x4*)(pr + COL_CQ + 8 * lane); const float a0 = bflo(w.x), a1 = bfhi(w.x), a2 = bflo(w.y), a3 = bfhi(w.y), a4 = bflo(w.z), a5 = bfhi(w.z), a6 = bflo(w.w), a7 = bfhi(w.w);
                        ss = (a0 * a0 + a1 * a1) + (a2 * a2 + a3 * a3) + (a4 * a4 + a5 * a5) + (a6 * a6 + a7 * a7); }
                    else { const u32x2 w = *(const u32x2*)(pr + COL_CKV + 4 * lane); const float a0 = bflo(w.x), a1 = bfhi(w.x), a2 = bflo(w.y), a3 = bfhi(w.y); ss = (a0 * a0 + a1 * a1) + (a2 * a2 + a3 * a3); }
                    ss = wave_sum(ss);
                    if (lane == 0) tab[32 * wave + r] = 1.f / sqrtf(ss * (mode == 0 ? 1.f / 512.f : 1.f / 256.f) + LN_EPS);
                }
                __syncthreads();
                pg8::Gemm g;
                if (mode == 0) g = pg8::Gemm{P + COL_CQ, (const bf16_t*)(ws + WS_WUQ), NIN, 512, 512};
                else if (mode == 1) g = pg8::Gemm{P + COL_CKV, (const bf16_t*)(ws + WS_WK), NIN, 256, 256};
                else g = pg8::Gemm{(const bf16_t*)(ws + WS_WV), P + COL_CKV, 256, NIN, 256};
                pg8::SingleUnit S; S.u0.pm = pm; S.u0.pn = pn;
                pg8::EpiLR E{mode, mode == 0 ? QA : (mode == 1 ? KN : VT), mode == 0 ? 1536 : (mode == 1 ? 1024 : M), tab, ROPE};
                pg8::gemm_phase<pg8::EpiLR, pg8::SingleUnit, false>(lds, g, S, E);
            }
            __syncthreads();
            {
                const float* conv_w = args.in[10]; const float* conv_b = args.in[11];
                for (int idx = bid * 512 + tid; idx < M * 128; idx += G * 512) {
                    const int row = idx >> 7, cgp = idx & 127, ch0 = 8 * cgp, sq = row & (SEQ - 1);
                    u32x4 xr[4];
#pragma unroll
                    for (int r = 0; r < 4; ++r) xr[r] = (sq - 3 + r >= 0) ? *(const u32x4*)(P + (size_t)(row - 3 + r) * NIN + ch0) : (u32x4){0u, 0u, 0u, 0u};
                    const float ksc = (ch0 < 512) ? 1.0f : 0.08838834764831845f;
                    unsigned ow[4];
#pragma unroll
                    for (int wd = 0; wd < 4; ++wd) {
                        float x0[4], x1[4];
#pragma unroll
                        for (int r = 0; r < 4; ++r) { const unsigned w = (wd == 0) ? xr[r].x : (wd == 1) ? xr[r].y : (wd == 2) ? xr[r].z : xr[r].w; x0[r] = bflo(w); x1[r] = bfhi(w); }
                        const int c0 = ch0 + 2 * wd;
                        float a0 = conv_b[c0], a1 = conv_b[c0 + 1];
#pragma unroll
                        for (int j = 0; j < 4; ++j) { a0 += conv_w[j * 1024 + c0] * x0[j]; a1 += conv_w[j * 1024 + c0 + 1] * x1[j]; }
                        ow[wd] = cvt_pk_bf16(silu_f(a0) * ksc, silu_f(a1) * ksc);
                    }
                    const u32x4 w = {ow[0], ow[1], ow[2], ow[3]};
                    if (ch0 < 512) *(u32x4*)(QC + (size_t)row * 512 + ch0) = w; else *(u32x4*)(KC + (size_t)row * 512 + (ch0 - 512)) = w;
                }
                LAS unsigned char* tl = lds + wave * 9216;
                for (int tix = gw; tix < 128 * 16; tix += NGW) {
                    const int tt = tix >> 4, et = tix & 15;
#pragma unroll
                    for (int c = 0; c < 8; ++c) {
                        const u32x4 v = *(const u32x4*)(P + (size_t)(tt * 64 + lane) * NIN + 1024 + et * 64 + 8 * c);
                        const unsigned wv[4] = {v.x, v.y, v.z, v.w};
#pragma unroll
                        for (int i = 0; i < 4; ++i) { *(LAS bf16_t*)(tl + (8 * c + 2 * i) * 144 + 2 * lane) = (bf16_t)(wv[i] & 0xffffu); *(LAS bf16_t*)(tl + (8 * c + 2 * i + 1) * 144 + 2 * lane) = (bf16_t)(wv[i] >> 16); }
                    }
                    LDS_WAIT(); asm volatile("" ::: "memory");
#pragma unroll
                    for (int c = 0; c < 8; ++c) { const u32x4 v = *(const LAS u32x4*)(tl + lane * 144 + 16 * c); *(u32x4*)(VTM + (size_t)(et * 64 + lane) * M + tt * 64 + 8 * c) = v; }
                    LDS_WAIT(); asm volatile("" ::: "memory");
                }
                if (gw < 16) {
                    const int b = gw >> 2, h = gw & 3; const float big = args.in[12][h], bfg = args.in[13][h];
                    const float* gp = GATES + (size_t)(b * SEQ + 32 * lane) * 8;
                    float ev[32], cv[32];
#pragma unroll
                    for (int i = 0; i < 32; ++i) { ev[i] = gp[i * 8 + h] + big; const float fp = gp[i * 8 + 4 + h] + bfg; cv[i] = fminf(fp, 0.f) - log1pf(__expf(-fabsf(fp))); }
#pragma unroll
                    for (int i = 1; i < 32; ++i) cv[i] += cv[i - 1];
                    float tot = cv[31], inc = tot;
#pragma unroll
                    for (int d = 1; d < 64; d <<= 1) { const float t = __shfl_up(inc, d); if (lane >= d) inc += t; }
                    const float off = inc - tot;
#pragma unroll
                    for (int i = 0; i < 32; ++i) ev[i] = (ev[i] - (cv[i] + off)) * 1.4426950408889634f;
#pragma unroll
                    for (int i = 0; i < 32; ++i) cv[i] = (i == 0) ? ev[0] : fmaxf(cv[i - 1], ev[i]);
                    float mx = cv[31];
#pragma unroll
                    for (int d = 1; d < 64; d <<= 1) { const float t = __shfl_up(mx, d); if (lane >= d) mx = fmaxf(mx, t); }
                    float mo = __shfl_up(mx, 1); if (lane == 0) mo = -1e30f;
                    float* eo = EG + gw * SEQ + 32 * lane; float* mo_ = MG + gw * SEQ + 32 * lane;
#pragma unroll
                    for (int i = 0; i < 32; i += 4) {
                        *(f32x4*)(eo + i) = (f32x4){ev[i], ev[i + 1], ev[i + 2], ev[i + 3]};
                        *(f32x4*)(mo_ + i) = (f32x4){fmaxf(cv[i], mo), fmaxf(cv[i + 1], mo), fmaxf(cv[i + 2], mo), fmaxf(cv[i + 3], mo)};
                    }
                }
            }
    }
    GRID_SYNC();
    for (int rep_ = 0; rep_ < ((7 == DBG_REP_PH) ? 2 : 1); ++rep_) { constexpr int ph = 7; PH_THREAD(); if (rep_) { asm volatile("s_waitcnt vmcnt(0)" ::: "memory"); __syncthreads(); }
#if !DBG_NO_MLSTM
            for (int it = bid; it < 128; it += G) {
                const int bh = it >> 3, eh = (it >> 2) & 1, pr = it & 3;
                mlp_unit(QC, KC, VTM, EG, MG, HRAW, bh >> 2, bh & 3, 7 - pr, eh, lds, tid, wave, lane);
                mlp_unit(QC, KC, VTM, EG, MG, HRAW, bh >> 2, bh & 3, pr, eh, lds, tid, wave, lane);
            }
#endif
#if !DBG_NO_ATTN
            for (int it = bid; it < 256; it += G) {
                if (it < 128) continue;
                const int a = it - 128, bh = a >> 2, pr = a & 3;
                attn_unit(QA, KN, P, VT, HM, bh >> 3, bh & 7, 7 - pr, lds, tid, wave, lane);
                attn_unit(QA, KN, P, VT, HM, bh >> 3, bh & 7, pr, lds, tid, wave, lane);
            }
#endif
    }
    GRID_SYNC();
    for (int rep_ = 0; rep_ < ((8 == DBG_REP_PH) ? 2 : 1); ++rep_) { constexpr int ph = 8; PH_THREAD(); if (rep_) { asm volatile("s_waitcnt vmcnt(0)" ::: "memory"); __syncthreads(); }
            const float* mg = args.in[14];
            for (int row = gw; row < M; row += NGW) {
#pragma unroll
                for (int hh = 0; hh < 4; ++hh) {
#if DBG_NO_MLSTM
                    f32x4 v = {0.f, 0.f, 0.f, 0.f};
#else
                    f32x4 v = *((const f32x4*)(HRAW + (size_t)row * 1024 + hh * 256) + lane);
#endif
                    const float mean = wave_sum((v[0] + v[1]) + (v[2] + v[3])) * (1.f / 256.f);
                    v = v - mean;
                    const float rstd = 1.f / sqrtf(wave_sum((v[0] * v[0] + v[1] * v[1]) + (v[2] * v[2] + v[3] * v[3])) * (1.f / 256.f) + LN_EPS);
                    const f32x4 gg = *((const f32x4*)(mg + hh * 256) + lane);
                    const u32x2 ow = *((const u32x2*)(P + (size_t)row * NIN + 2048 + hh * 256) + lane);
                    const float o0 = bflo(ow.x), o1 = bfhi(ow.x), o2 = bflo(ow.y), o3 = bfhi(ow.y);
                    f32x4 y = v * rstd * gg;
                    y[0] *= 1.f / (1.f + __expf(-o0)); y[1] *= 1.f / (1.f + __expf(-o1)); y[2] *= 1.f / (1.f + __expf(-o2)); y[3] *= 1.f / (1.f + __expf(-o3));
                    u32x2 w; w.x = cvt_pk_bf16(y[0], y[1]); w.y = cvt_pk_bf16(y[2], y[3]);
                    *((u32x2*)(HM + (size_t)row * D + hh * 256) + lane) = w;
#if DBG_NO_ATTN
                    *((u32x2*)(HM + (size_t)row * D + 1024 + hh * 256) + lane) = (u32x2){0u, 0u};
#endif
                }
            }
            }
    GRID_SYNC();
    for (int rep_ = 0; rep_ < ((9 == DBG_REP_PH) ? 2 : 1); ++rep_) { constexpr int ph = 9; PH_THREAD(); if (rep_) { asm volatile("s_waitcnt vmcnt(0)" ::: "memory"); __syncthreads(); }
            const int s = (ph == 3) ? 0 : (ph == 9 ? 1 : 2);
            const bf16_t* A = (ph == 9) ? HM : Hb; const bf16_t* Wt = (const bf16_t*)(ws + (ph == 3 ? WS_W2A : (ph == 9 ? WS_WOUT : WS_W2B)));
            const int K = (ph == 9) ? D : FF;
            const float* Xr = (ph == 3) ? x_in : X;
            pg8::Gemm g{A, Wt, K, K, K}; pg8::StaticOrder S; S.init(M, D, G, bid);
            pg8::EpiResid E{Xr, Z, MOD + s * 6144 + 4096, (ph == 9) ? 1.0f : 0.5f};
            pg8::gemm_phase<pg8::EpiResid, pg8::StaticOrder, true>(lds, g, S, E);
            }
    GRID_SYNC();
    for (int rep_ = 0; rep_ < ((10 == DBG_REP_PH) ? 2 : 1); ++rep_) { constexpr int ph = 10; PH_THREAD(); if (rep_) { asm volatile("s_waitcnt vmcnt(0)" ::: "memory"); __syncthreads(); }
            const int s = (ph == 4) ? 1 : 2;
            const float* gp = args.in[ph == 4 ? 7 : (ph == 10 ? 20 : 25)]; const float* bp = args.in[ph == 4 ? 8 : (ph == 10 ? 21 : 26)];
            float* Xo = (ph == 13) ? args.out : X;
            for (int row = gw; row < M; row += NGW) {
                const int b = row >> 11; const float* mb = MOD + (size_t)b * NMOD + s * 6144;
                const f32x4* zr = (const f32x4*)(Z + (size_t)row * D) + lane;
                f32x4 v[8]; float sm = 0.f;
#pragma unroll
                for (int j = 0; j < 8; ++j) { v[j] = zr[64 * j]; sm += (v[j][0] + v[j][1]) + (v[j][2] + v[j][3]); }
                const float mean = wave_sum(sm) * (1.f / D); float s2 = 0.f;
#pragma unroll
                for (int j = 0; j < 8; ++j) { v[j] = v[j] - mean; s2 += (v[j][0] * v[j][0] + v[j][1] * v[j][1]) + (v[j][2] * v[j][2] + v[j][3] * v[j][3]); }
                const float rstd = 1.f / sqrtf(wave_sum(s2) * (1.f / D) + LN_EPS);
                f32x4* xo = (f32x4*)(Xo + (size_t)row * D) + lane; u32x2* ur = (u32x2*)(U + (size_t)row * D) + lane;
#pragma unroll
                for (int j = 0; j < 8; ++j) {
                    const f32x4 gg = *((const f32x4*)gp + lane + 64 * j), bb = *((const f32x4*)bp + lane + 64 * j);
                    const f32x4 y = v[j] * rstd * gg + bb; xo[64 * j] = y;
                    if (ph != 13) { const f32x4 sh = *((const f32x4*)mb + lane + 64 * j), scl = *((const f32x4*)(mb + 2048) + lane + 64 * j);
                        const f32x4 uu = y * (scl + 1.0f) + sh; u32x2 w; w.x = cvt_pk_bf16(uu[0], uu[1]); w.y = cvt_pk_bf16(uu[2], uu[3]); ur[64 * j] = w; }
                }
            }
            }
    GRID_SYNC();
    for (int rep_ = 0; rep_ < ((11 == DBG_REP_PH) ? 2 : 1); ++rep_) { constexpr int ph = 11; PH_THREAD(); if (rep_) { asm volatile("s_waitcnt vmcnt(0)" ::: "memory"); __syncthreads(); }
            const bf16_t* Wt = (const bf16_t*)(ws + (ph == 2 ? WS_W13A : WS_W13B));
            pg8::Gemm g{U, Wt, D, D, D}; pg8::StaticOrder S; S.init(M, 2 * FF, G, bid);
            pg8::EpiSwiglu E{Hb};
            pg8::gemm_phase<pg8::EpiSwiglu, pg8::StaticOrder, true>(lds, g, S, E);
            }
    GRID_SYNC();
    for (int rep_ = 0; rep_ < ((12 == DBG_REP_PH) ? 2 : 1); ++rep_) { constexpr int ph = 12; PH_THREAD(); if (rep_) { asm volatile("s_waitcnt vmcnt(0)" ::: "memory"); __syncthreads(); }
            const int s = (ph == 3) ? 0 : (ph == 9 ? 1 : 2);
            const bf16_t* A = (ph == 9) ? HM : Hb; const bf16_t* Wt = (const bf16_t*)(ws + (ph == 3 ? WS_W2A : (ph == 9 ? WS_WOUT : WS_W2B)));
            const int K = (ph == 9) ? D : FF;
            const float* Xr = (ph == 3) ? x_in : X;
            pg8::Gemm g{A, Wt, K, K, K}; pg8::StaticOrder S; S.init(M, D, G, bid);
            pg8::EpiResid E{Xr, Z, MOD + s * 6144 + 4096, (ph == 9) ? 1.0f : 0.5f};
            pg8::gemm_phase<pg8::EpiResid, pg8::StaticOrder, true>(lds, g, S, E);
            }
    GRID_SYNC();
    for (int rep_ = 0; rep_ < ((13 == DBG_REP_PH) ? 2 : 1); ++rep_) { constexpr int ph = 13; PH_THREAD(); if (rep_) { asm volatile("s_waitcnt vmcnt(0)" ::: "memory"); __syncthreads(); }
            const int s = (ph == 4) ? 1 : 2;
            const float* gp = args.in[ph == 4 ? 7 : (ph == 10 ? 20 : 25)]; const float* bp = args.in[ph == 4 ? 8 : (ph == 10 ? 21 : 26)];
            float* Xo = (ph == 13) ? args.out : X;
            for (int row = gw; row < M; row += NGW) {
                const int b = row >> 11; const float* mb = MOD + (size_t)b * NMOD + s * 6144;
                const f32x4* zr = (const f32x4*)(Z + (size_t)row * D) + lane;
                f32x4 v[8]; float sm = 0.f;
#pragma unroll
                for (int j = 0; j < 8; ++j) { v[j] = zr[64 * j]; sm += (v[j][0] + v[j][1]) + (v[j][2] + v[j][3]); }
                const float mean = wave_sum(sm) * (1.f / D); float s2 = 0.f;
#pragma unroll
                for (int j = 0; j < 8; ++j) { v[j] = v[j] - mean; s2 += (v[j][0] * v[j][0] + v[j][1] * v[j][1]) + (v[j][2] * v[j][2] + v[j][3] * v[j][3]); }
                const float rstd = 1.f / sqrtf(wave_sum(s2) * (1.f / D) + LN_EPS);
                f32x4* xo = (f32x4*)(Xo + (size_t)row * D) + lane; u32x2* ur = (u32x2*)(U + (size_t)row * D) + lane;
#pragma unroll
                for (int j = 0; j < 8; ++j) {
                    const f32x4 gg = *((const f32x4*)gp + lane + 64 * j), bb = *((const f32x4*)bp + lane + 64 * j);
                    const f32x4 y = v[j] * rstd * gg + bb; xo[64 * j] = y;
                    if (ph != 13) { const f32x4 sh = *((const f32x4*)mb + lane + 64 * j), scl = *((const f32x4*)(mb + 2048) + lane + 64 * j);
                        const f32x4 uu = y * (scl + 1.0f) + sh; u32x2 w; w.x = cvt_pk_bf16(uu[0], uu[1]); w.y = cvt_pk_bf16(uu[2], uu[3]); ur[64 * j] = w; }
                }
            }
            }
}

extern "C" void kernel_launch(void* const* d_in, const int* in_sizes, int n_in, void* d_out, int out_size, void* d_ws, size_t ws_size, hipStream_t stream) {
    static int grid = 0;
    if (grid == 0) {
        if (n_in != 27 || out_size != M * D || ws_size < WS_END) { fprintf(stderr, "kernel_launch: unexpected shapes (n_in %d out %d ws %zu need %zu)\n", n_in, out_size, ws_size, (size_t)WS_END); grid = -1; return; }
        int dev = 0, cus = 0, per_cu = 0;
        hipGetDevice(&dev); hipDeviceGetAttribute(&cus, hipDeviceAttributeMultiprocessorCount, dev);
        if (hipFuncSetAttribute((const void*)fwd_kernel, hipFuncAttributeMaxDynamicSharedMemorySize, LDS_BYTES) != hipSuccess) { fprintf(stderr, "kernel_launch: hipFuncSetAttribute failed\n"); grid = -1; return; }
        hipOccupancyMaxActiveBlocksPerMultiprocessor(&per_cu, (const void*)fwd_kernel, 512, LDS_BYTES);
        (void)hipGetLastError();
        if (per_cu < 1) { fprintf(stderr, "kernel_launch: occupancy query says %d blocks/CU\n", per_cu); per_cu = 1; }
        grid = cus;
    }
    if (grid < 0) return;
    Args a{};
    for (int i = 0; i < 27; ++i) a.in[i] = (const float*)d_in[i];
    a.out = (float*)d_out; a.ws = (unsigned char*)d_ws;
    void* kargs[] = {&a};
    hipError_t e = hipLaunchCooperativeKernel((const void*)fwd_kernel, dim3(grid), dim3(512), kargs, LDS_BYTES, stream);
    if (e != hipSuccess) fprintf(stderr, "kernel_launch: cooperative launch failed: %s (grid %d)\n", hipGetErrorString(e), grid);
}
```

```cpp
#include <hip/hip_runtime.h>
#include <hip/hip_cooperative_groups.h>
#include <cstdio>
#include <cstdint>
namespace cg = cooperative_groups;

#define LAS __attribute__((address_space(3)))
typedef unsigned short bf16_t;
typedef short bf16x8 __attribute__((ext_vector_type(8)));
typedef short bf16x4 __attribute__((ext_vector_type(4)));
typedef float f32x4 __attribute__((ext_vector_type(4)));
typedef float f32x2 __attribute__((ext_vector_type(2)));
typedef float f32x16 __attribute__((ext_vector_type(16)));
typedef unsigned u32x4 __attribute__((ext_vector_type(4)));
typedef unsigned u32x2 __attribute__((ext_vector_type(2)));

#ifndef DBG_NO_MLSTM
#define DBG_NO_MLSTM 0
#endif
#ifndef DBG_WHICH
#define DBG_WHICH 7
#endif
#ifndef DBG_SELFTEST
#define DBG_SELFTEST 0
#endif
#ifndef DBG_XSYNC
#define DBG_XSYNC 0
#endif
#ifndef DBG_MIX2
#define DBG_MIX2 0
#endif
#ifndef DBG_REP_SUB
#define DBG_REP_SUB 0
#endif
#ifndef DBG_REP_PH
#define DBG_REP_PH -1
#endif
#ifndef DBG_NO_ATTN
#define DBG_NO_ATTN 0
#endif

constexpr int SEQ = 2048, NB = 4, M = NB * SEQ, D = 2048, FF = 5632, NIN = 4096, DIN = 3912, NMOD = 18432;
constexpr float ALPHA = 1.189207115002721f;
constexpr float LN_EPS = 1e-5f;
constexpr float QSCALE = 0.07216878364870322f * 1.4426950408889634f;
constexpr int COL_CQ = 3080, COL_CKV = 3592, COL_KR = 3848;

constexpr size_t MiB = 1u << 20;
constexpr size_t WS_MOD = 1 * MiB, WS_ROPE = 2 * MiB, WS_GATES = 3 * MiB;
constexpr size_t WS_W13A = 4 * MiB, WS_W2A = 48 * MiB, WS_W13B = 70 * MiB, WS_W2B = 114 * MiB;
constexpr size_t WS_WIN = 136 * MiB, WS_WUQ = 152 * MiB, WS_WK = 154 * MiB, WS_WV = WS_WK + 524288, WS_WOUT = 156 * MiB;
constexpr size_t WS_U = 164 * MiB, WS_Z = 196 * MiB, WS_X = 260 * MiB, WS_R = 324 * MiB;
constexpr size_t WS_H = WS_R;
constexpr size_t WS_P = WS_R, WS_QA = WS_R + 64 * MiB, WS_KN = WS_R + 88 * MiB, WS_VT = WS_R + 104 * MiB, WS_HM = WS_R + 120 * MiB, WS_HRAW = WS_R + 152 * MiB;
constexpr size_t WS_QC = WS_R + 184 * MiB, WS_KC = WS_R + 192 * MiB, WS_VTM = WS_R + 200 * MiB, WS_EG = WS_R + 216 * MiB, WS_MG = WS_EG + 131072;
constexpr size_t WS_END = WS_R + 217 * MiB;

constexpr int LDS_BYTES = 147456;
constexpr int TAB_OFF = 131072 + 1024;

__device__ __forceinline__ unsigned cvt_pk_bf16(float lo, float hi) { unsigned r; asm volatile("v_cvt_pk_bf16_f32 %0, %1, %2" : "=v"(r) : "v"(lo), "v"(hi)); return r; }
__device__ __forceinline__ float bf2f(unsigned short b) { return __builtin_bit_cast(float, (unsigned)b << 16); }
__device__ __forceinline__ float bflo(unsigned w) { return __builtin_bit_cast(float, w << 16); }
__device__ __forceinline__ float bfhi(unsigned w) { return __builtin_bit_cast(float, w & 0xffff0000u); }
__device__ __forceinline__ float wave_sum(float v) {
#pragma unroll
    for (int o = 1; o < 64; o <<= 1) v += __shfl_xor(v, o);
    return v;
}
__device__ __forceinline__ float silu_f(float a) { return a * __builtin_amdgcn_rcpf(1.f + __expf(-a)); }
#define LDS_WAIT() asm volatile("s_waitcnt lgkmcnt(0)" ::: "memory")
__device__ __forceinline__ int opaque_int(int v) { asm volatile("" : "+s"(v)); return v; }
__device__ __forceinline__ int opaque_tid() { int t = threadIdx.x; asm volatile("" : "+v"(t)); return t; }


#define XB_TMO      128
#define XB_XCNT(j)  (256  + 64 * (j))
#define XB_XSUB(j)  (1280 + 64 * (j))
#define XB_XGEN(j)  (2304 + 64 * (j))
#define XB_TOP      3328
#define XB_TOPGEN   3392
#define XCD_BAR_WORDS 3456
#define XB_SPIN_CAP (1u << 18)
__device__ __forceinline__ unsigned xb_ld(unsigned* p)              { return __hip_atomic_load(p, __ATOMIC_RELAXED, __HIP_MEMORY_SCOPE_AGENT); }
__device__ __forceinline__ unsigned xb_add(unsigned* p, unsigned v) { return __hip_atomic_fetch_add(p, v, __ATOMIC_RELAXED, __HIP_MEMORY_SCOPE_AGENT); }
__device__ __forceinline__ unsigned xb_xcc_id() { return (unsigned)__builtin_amdgcn_s_getreg((3 << 11) | 20) & 0xFu; }
#define XB_SPIN(cond, bar) do { unsigned _sp = 0; while (cond) { __builtin_amdgcn_s_sleep(1); \
    if ((++_sp & 255u) == 0u) { if (xb_ld(&(bar)[XB_TMO])) break; if (_sp > XB_SPIN_CAP) { atomicAdd(&(bar)[XB_TMO], 1u); break; } } } } while (0)
struct XcdBarrier { unsigned* bar; unsigned x; volatile LAS unsigned* st; };
__device__ __forceinline__ XcdBarrier xcd_barrier_post(unsigned* bar, volatile LAS unsigned* st) {
    XcdBarrier b; b.bar = bar; b.x = xb_xcc_id(); b.st = st;
    if (threadIdx.x == 0) (void)xb_add(&bar[XB_XCNT(b.x)], 1u);
    return b;
}
__device__ __forceinline__ void xcd_barrier_complete(unsigned* bar, unsigned x, unsigned& nloc, unsigned& nx) {
    const unsigned G = gridDim.x * gridDim.y * gridDim.z;
    unsigned sum, cnt, mine, sp = 0u;
    for (;;) {
        sum = 0u; cnt = 0u; mine = 0u;
#pragma unroll
        for (unsigned j = 0; j < 16; ++j) { const unsigned c = xb_ld(&bar[XB_XCNT(j)]); sum += c; cnt += (c > 0u) ? 1u : 0u; mine = (j == x) ? c : mine; }
        if (sum == G) break;
        __builtin_amdgcn_s_sleep(1);
        if ((++sp & 255u) == 0u) { if (xb_ld(&bar[XB_TMO])) break; if (sp > XB_SPIN_CAP) { atomicAdd(&bar[XB_TMO], 1u); break; } }
    }
    nloc = mine > 0u ? mine : 1u; nx = cnt > 0u ? cnt : 1u;
}
__device__ __forceinline__ void xcd_barrier(const XcdBarrier& b) {
    asm volatile("s_waitcnt vmcnt(0)" ::: "memory");
    __syncthreads();
    if (threadIdx.x == 0) {
        unsigned* bar = b.bar;
        __builtin_amdgcn_s_waitcnt(0);
        unsigned nloc = b.st[0], nx = b.st[1];
        if (nloc == 0u) { xcd_barrier_complete(bar, b.x, nloc, nx); b.st[0] = nloc; b.st[1] = nx; }
        const unsigned old = xb_add(&bar[XB_XSUB(b.x)], 1u);
        const unsigned gen = old / nloc;
        if (old + 1u == (gen + 1u) * nloc) {
            __builtin_amdgcn_fence(__ATOMIC_RELEASE, "agent");
            asm volatile("s_waitcnt vmcnt(0)" ::: "memory");
            const unsigned og = xb_add(&bar[XB_TOP], 1u);
            const unsigned tg = og / nx;
            if (og + 1u == (tg + 1u) * nx) xb_add(&bar[XB_TOPGEN], 1u);
            else XB_SPIN(xb_ld(&bar[XB_TOPGEN]) == tg, bar);
            __builtin_amdgcn_fence(__ATOMIC_ACQUIRE, "agent");
            xb_add(&bar[XB_XGEN(b.x)], 1u);
            asm volatile("s_waitcnt vmcnt(0)" ::: "memory");
        } else {
            XB_SPIN(xb_ld(&bar[XB_XGEN(b.x)]) == gen, bar);
            __builtin_amdgcn_fence(__ATOMIC_ACQUIRE, "agent");
            asm volatile("s_waitcnt vmcnt(0)" ::: "memory");
        }
    }
    __syncthreads();
}

namespace pg8 {
constexpr int BM = 256, BK = 64, HALF = 128, HTB = HALF * BK * 2, STAGE_BYTES = 8 * HTB, NXCD = 8, WGM = 8;
__host__ __device__ __forceinline__ int lds_byte(int r, int c) { const int st = (r >> 4) * 2 + (c >> 5), rr = r & 15, cc = c & 31, ob = rr * 64 + cc * 2; return st * 1024 + (ob ^ (((ob >> 9) & 1) << 5)); }
__host__ __device__ __forceinline__ void stage_rc(int b, int& R, int& C) { const int st = b / 1024, sb = b % 1024, swz = sb ^ (((sb >> 9) & 1) << 5); R = (st >> 1) * 16 + swz / 64; C = (st & 1) * 32 + (swz % 64) / 2; }
__host__ __device__ __forceinline__ int perm32(int rho) { const int n = rho >> 4, i = rho & 15; return 8 * (i >> 2) + 4 * n + (i & 3); }

struct Unit { int pm, pn; };
struct Gemm { const bf16_t* A; const bf16_t* Bt; int lda, ldb, K; };

struct StaticOrder {
    int nM, nN, nwg, G, c;
    __device__ void init(int Mr, int Nc, int G_, int c_) { nM = Mr / BM; nN = Nc / BM; nwg = nM * nN; G = G_; c = c_; }
    __device__ bool next(int i, Unit& u) const {
        const long L = (long)i * G + c; if (L >= nwg) return false;
        int wgid = (int)L; { const int q = nwg / NXCD, r = nwg % NXCD, xcd = wgid % NXCD, off = wgid / NXCD; wgid = (xcd < r ? xcd * (q + 1) : r * (q + 1) + (xcd - r) * q) + off; }
        const int nig = WGM * nN, gid = wgid / nig, fm = gid * WGM, gsz = (nM - fm) < WGM ? (nM - fm) : WGM;
        u.pm = fm + ((wgid % nig) % gsz); u.pn = (wgid % nig) / gsz; return true;
    }
};
struct SingleUnit { Unit u0; __device__ bool next(int i, Unit& u) const { if (i != 0) return false; u = u0; return true; } };

template <class Epi, class Sched, bool ALIGN_EPI>
__device__ __forceinline__ void gemm_phase(LAS unsigned char* lds, const Gemm g, const Sched& S, const Epi& E) {
    const int tid = opaque_tid(), wid = __builtin_amdgcn_readfirstlane(tid >> 6), lane = tid & 63, wr = wid >> 2, wc = wid & 3, fr = lane & 15, fq = lane >> 4;
    const int K = g.K, nt = K / BK;
    unsigned voffA[2], voffB[2];
#pragma unroll
    for (int i = 0; i < 2; ++i) { int R, C; stage_rc(tid * 16 + i * 8192, R, C); const int Rb = Epi::PERM ? ((R & ~31) + perm32(R & 31)) : R;
        voffA[i] = (unsigned)(R * g.lda + C) * 2u; voffB[i] = (unsigned)(Rb * g.ldb + C) * 2u; }
    const size_t kstep = (size_t)(BK * 2);
    const size_t hstepA = (size_t)HALF * g.lda * 2, hstepB = (size_t)HALF * g.ldb * 2;
    const size_t tstepA = 2 * hstepA, tstepB = 2 * hstepB;
    const unsigned ldsw = (unsigned)wid * 1024u;
    const int aoff = lds_byte(wr * 64 + fr, fq * 8), boff = lds_byte(wc * 32 + fr, fq * 8);
#define PG8_SA(b, h) (((b) * 2 + (h)) * HTB)
#define PG8_SB(b, h) ((4 + (b) * 2 + (h)) * HTB)
#define PG8_STAGE(bufoff, gbase, voff) do { _Pragma("unroll") for (int _i = 0; _i < 2; ++_i) \
        __builtin_amdgcn_global_load_lds((const unsigned*)((const char*)(gbase) + (voff)[_i]), (LAS unsigned*)(lds + (bufoff) + ldsw + _i * 8192), 16, 0, 0); } while (0)
#define PG8_LDA(dst, b, h) do { _Pragma("unroll") for (int m = 0; m < 4; ++m) _Pragma("unroll") for (int k = 0; k < 2; ++k) dst[m][k] = *(const LAS bf16x8*)(lds + PG8_SA(b, h) + aoff + m * 2048 + k * 1024); } while (0)
#define PG8_LDB(dst, b, h) do { _Pragma("unroll") for (int n = 0; n < 2; ++n) _Pragma("unroll") for (int k = 0; k < 2; ++k) dst[n][k] = *(const LAS bf16x8*)(lds + PG8_SB(b, h) + boff + n * 2048 + k * 1024); } while (0)
#define PG8_MMA(ai, bj, At, Bt) do { __builtin_amdgcn_s_setprio(1); _Pragma("unroll") for (int m = 0; m < 4; ++m) _Pragma("unroll") for (int n = 0; n < 2; ++n) _Pragma("unroll") for (int k = 0; k < 2; ++k) \
        acc[ai][bj][m][n] = __builtin_amdgcn_mfma_f32_16x16x32_bf16(Bt[n][k], At[m][k], acc[ai][bj][m][n], 0, 0, 0); __builtin_amdgcn_s_setprio(0); } while (0)
#define PG8_WAIT_V(n) asm volatile("s_waitcnt vmcnt(" #n ")" ::: "memory")
#define PG8_WAIT_L(n) asm volatile("s_waitcnt lgkmcnt(" #n ")" ::: "memory")
#define PG8_BAR __builtin_amdgcn_s_barrier()
#define PG8_SCHED __builtin_amdgcn_sched_barrier(0)
    Unit cur, nxt; int ui = 0;
    if (!S.next(0, cur)) return;
    f32x4 acc[2][2][4][2];
#pragma unroll
    for (int a = 0; a < 2; ++a)
#pragma unroll
        for (int b = 0; b < 2; ++b)
#pragma unroll
            for (int m = 0; m < 4; ++m)
#pragma unroll
                for (int n = 0; n < 2; ++n) acc[a][b][m][n] = (f32x4){0.f, 0.f, 0.f, 0.f};
    bf16x8 At[4][2], B0[2][2], B1[2][2];
    const char* cA = (const char*)g.A + (size_t)cur.pm * tstepA; const char* cB = (const char*)g.Bt + (size_t)cur.pn * tstepB;
    PG8_STAGE(PG8_SB(0, 0), cB, voffB); PG8_STAGE(PG8_SB(0, 1), cB + hstepB, voffB); PG8_STAGE(PG8_SA(0, 0), cA, voffA); PG8_STAGE(PG8_SA(0, 1), cA + hstepA, voffA);
    if (wr == 1) PG8_BAR;
    PG8_WAIT_V(2); PG8_BAR;
    PG8_STAGE(PG8_SB(1, 0), cB + kstep, voffB); PG8_STAGE(PG8_SA(1, 0), cA + kstep, voffA); PG8_STAGE(PG8_SB(1, 1), cB + hstepB + kstep, voffB);
    PG8_WAIT_V(6); PG8_BAR;
    for (;;) {
        const bool has_next = S.next(ui + 1, nxt);
        const char* nA = has_next ? (const char*)g.A + (size_t)nxt.pm * tstepA : cA; const char* nB = has_next ? (const char*)g.Bt + (size_t)nxt.pn * tstepB : cB;
        for (int t = 0; t < nt; t += 2) {
            const bool last = (t == nt - 2);
            const char* a1 = cA + (size_t)(t + 1) * kstep;
            const char* a2 = last ? nA : cA + (size_t)(t + 2) * kstep; const char* b2 = last ? nB : cB + (size_t)(t + 2) * kstep;
            const char* a3 = a2 + kstep; const char* b3 = b2 + kstep;
            PG8_LDB(B0, 0, 0); PG8_LDB(B1, 0, 1); PG8_SCHED; PG8_LDA(At, 0, 0); PG8_STAGE(PG8_SA(1, 1), a1 + hstepA, voffA);
            PG8_WAIT_V(8); PG8_WAIT_L(0); PG8_BAR; PG8_MMA(0, 0, At, B0); PG8_MMA(0, 1, At, B1); PG8_BAR; PG8_SCHED;
            PG8_LDA(At, 0, 1); PG8_STAGE(PG8_SB(0, 0), b2, voffB); PG8_STAGE(PG8_SB(0, 1), b2 + hstepB, voffB); PG8_STAGE(PG8_SA(0, 0), a2, voffA);
            PG8_WAIT_V(8); PG8_WAIT_L(0); PG8_BAR; PG8_MMA(1, 0, At, B0); PG8_MMA(1, 1, At, B1); PG8_BAR; PG8_SCHED;
            PG8_LDB(B0, 1, 0); PG8_LDB(B1, 1, 1); PG8_SCHED; PG8_LDA(At, 1, 0); PG8_STAGE(PG8_SA(0, 1), a2 + hstepA, voffA);
            PG8_WAIT_V(8); PG8_WAIT_L(0); PG8_BAR; PG8_MMA(0, 0, At, B0); PG8_MMA(0, 1, At, B1); PG8_BAR; PG8_SCHED;
            PG8_LDA(At, 1, 1); PG8_STAGE(PG8_SB(1, 0), b3, voffB); PG8_STAGE(PG8_SB(1, 1), b3 + hstepB, voffB); PG8_STAGE(PG8_SA(1, 0), a3, voffA);
            PG8_WAIT_V(8); PG8_WAIT_L(0); PG8_BAR; PG8_MMA(1, 0, At, B0); PG8_MMA(1, 1, At, B1); PG8_BAR; PG8_SCHED;
        }
        if constexpr (ALIGN_EPI) { if (wr == 0) PG8_BAR; }
        E(acc, cur, wr, wc, fr, fq);
        if (!has_next) break;
#pragma unroll
        for (int a = 0; a < 2; ++a)
#pragma unroll
            for (int b = 0; b < 2; ++b)
#pragma unroll
                for (int m = 0; m < 4; ++m)
#pragma unroll
                    for (int n = 0; n < 2; ++n) acc[a][b][m][n] = (f32x4){0.f, 0.f, 0.f, 0.f};
        cur = nxt; cA = nA; cB = nB; ++ui;
        if constexpr (ALIGN_EPI) { if (wr == 1) PG8_BAR; }
    }
    PG8_WAIT_V(0);
    if constexpr (!ALIGN_EPI) { if (wr == 0) PG8_BAR; }
    PG8_BAR;
#undef PG8_SA
#undef PG8_SB
#undef PG8_STAGE
#undef PG8_LDA
#undef PG8_LDB
#undef PG8_MMA
#undef PG8_WAIT_V
#undef PG8_WAIT_L
#undef PG8_BAR
#undef PG8_SCHED
}

typedef f32x4 Acc[2][2][4][2];

struct EpiSwiglu {
    static constexpr bool PERM = true;
    bf16_t* H;
    __device__ __forceinline__ void operator()(const Acc& acc, const Unit& u, int wr, int wc, int fr, int fq) const {
        const int row0 = u.pm * BM + wr * 64 + fr, col0 = u.pn * 128 + wc * 32 + 8 * fq;
#pragma unroll
        for (int ai = 0; ai < 2; ++ai)
#pragma unroll
            for (int m = 0; m < 4; ++m) {
                const f32x4 a0 = acc[ai][0][m][0], a1 = acc[ai][0][m][1], b0 = acc[ai][1][m][0], b1 = acc[ai][1][m][1];
                u32x4 w;
                w.x = cvt_pk_bf16(silu_f(a0[0]) * b0[0], silu_f(a0[1]) * b0[1]); w.y = cvt_pk_bf16(silu_f(a0[2]) * b0[2], silu_f(a0[3]) * b0[3]);
                w.z = cvt_pk_bf16(silu_f(a1[0]) * b1[0], silu_f(a1[1]) * b1[1]); w.w = cvt_pk_bf16(silu_f(a1[2]) * b1[2], silu_f(a1[3]) * b1[3]);
                *(u32x4*)(H + (size_t)(row0 + ai * HALF + m * 16) * FF + col0) = w;
            }
    }
};
struct EpiResid {
    static constexpr bool PERM = false;
    const float* X; float* Z; const float* gate; float coef;
    __device__ __forceinline__ void operator()(const Acc& acc, const Unit& u, int wr, int wc, int fr, int fq) const {
        const int row0 = u.pm * BM + wr * 64 + fr, b = u.pm >> 3, colb = u.pn * BM + wc * 32 + 4 * fq;
#pragma unroll
        for (int bj = 0; bj < 2; ++bj)
#pragma unroll
            for (int n = 0; n < 2; ++n) {
                const int col = colb + bj * HALF + n * 16;
                f32x4 gv = *(const f32x4*)(gate + (size_t)b * NMOD + col); gv = (gv + 1.0f) * coef;
#pragma unroll
                for (int ai = 0; ai < 2; ++ai)
#pragma unroll
                    for (int m = 0; m < 4; ++m) {
                        const size_t off = (size_t)(row0 + ai * HALF + m * 16) * D + col;
                        const f32x4 x = *(const f32x4*)(X + off);
                        *(f32x4*)(Z + off) = x * ALPHA + gv * acc[ai][bj][m][n];
                    }
            }
    }
};
__device__ __forceinline__ void rope8(f32x4& v0, f32x4& v1, const f32x2* cs) {
    const f32x2 c0 = cs[0], c1 = cs[1], c2 = cs[2], c3 = cs[3];
    float a, b;
    a = v0[0]; b = v0[1]; v0[0] = a * c0.x - b * c0.y; v0[1] = a * c0.y + b * c0.x;
    a = v0[2]; b = v0[3]; v0[2] = a * c1.x - b * c1.y; v0[3] = a * c1.y + b * c1.x;
    a = v1[0]; b = v1[1]; v1[0] = a * c2.x - b * c2.y; v1[1] = a * c2.y + b * c2.x;
    a = v1[2]; b = v1[3]; v1[2] = a * c3.x - b * c3.y; v1[3] = a * c3.y + b * c3.x;
}
struct EpiWin {
    static constexpr bool PERM = true;
    bf16_t* P; float* GATES; const f32x2* ROPE;
    __device__ __forceinline__ void operator()(const Acc& acc, const Unit& u, int wr, int wc, int fr, int fq) const {
        const int row0 = u.pm * BM + wr * 64 + fr, colb = u.pn * BM + wc * 32 + 8 * fq;
#pragma unroll
        for (int bj = 0; bj < 2; ++bj) {
            const int col = colb + bj * HALF;
            const bool isg = (col == 3072), isr = (col >= COL_KR && col < COL_KR + 64);
#pragma unroll
            for (int ai = 0; ai < 2; ++ai)
#pragma unroll
                for (int m = 0; m < 4; ++m) {
                    const int row = row0 + ai * HALF + m * 16;
                    f32x4 v0 = acc[ai][bj][m][0], v1 = acc[ai][bj][m][1];
                    if (isg) { *(f32x4*)(GATES + (size_t)row * 8) = v0; *(f32x4*)(GATES + (size_t)row * 8 + 4) = v1; }
                    if (isr) rope8(v0, v1, ROPE + (size_t)(row & (SEQ - 1)) * 32 + ((col - COL_KR) >> 1));
                    u32x4 w; w.x = cvt_pk_bf16(v0[0], v0[1]); w.y = cvt_pk_bf16(v0[2], v0[3]); w.z = cvt_pk_bf16(v1[0], v1[1]); w.w = cvt_pk_bf16(v1[2], v1[3]);
                    *(u32x4*)(P + (size_t)row * NIN + col) = w;
                }
        }
    }
};
struct EpiLR {
    static constexpr bool PERM = true;
    int mode; bf16_t* O; int ldo; const LAS float* tab; const f32x2* ROPE;
    __device__ __forceinline__ void operator()(const Acc& acc, const Unit& u, int wr, int wc, int fr, int fq) const {
#pragma unroll
        for (int bj = 0; bj < 2; ++bj) {
            const int lcol = wc * 32 + 8 * fq + bj * HALF, col = u.pn * BM + lcol;
            f32x4 c0 = {1.f, 1.f, 1.f, 1.f}, c1 = c0;
            if (mode == 2) { c0 = *(const LAS f32x4*)(tab + lcol); c1 = *(const LAS f32x4*)(tab + lcol + 4); }
            const int within = col % 192;
            const bool isr = (mode == 0) && (within >= 128);
#pragma unroll
            for (int ai = 0; ai < 2; ++ai)
#pragma unroll
                for (int m = 0; m < 4; ++m) {
                    const int lrow = wr * 64 + fr + ai * HALF + m * 16, row = u.pm * BM + lrow;
                    f32x4 v0 = acc[ai][bj][m][0] * c0, v1 = acc[ai][bj][m][1] * c1;
                    if (mode != 2) { float r = tab[lrow]; if (mode == 0) r *= QSCALE; v0 = v0 * r; v1 = v1 * r; }
                    if (isr) rope8(v0, v1, ROPE + (size_t)(row & (SEQ - 1)) * 32 + ((within - 128) >> 1));
                    u32x4 w; w.x = cvt_pk_bf16(v0[0], v0[1]); w.y = cvt_pk_bf16(v0[2], v0[3]); w.z = cvt_pk_bf16(v1[0], v1[1]); w.w = cvt_pk_bf16(v1[2], v1[3]);
                    *(u32x4*)(O + (size_t)row * ldo + col) = w;
                }
        }
    }
};
}

__device__ __forceinline__ int map_row(int kind, int n) {
    switch (kind) {
        case 0: return (n >> 7) * 256 + (n & 127);
        case 1: return (n >> 7) * 256 + 128 + (n & 127);
        case 3: { if (n < COL_KR) return n; const int j = n - COL_KR; return COL_KR + ((j < 32) ? 2 * j : 2 * (j - 32) + 1); }
        case 4: { const int h = n / 192, r = n - h * 192; if (r < 128) return n; const int j = r - 128; return h * 192 + 128 + ((j < 32) ? 2 * j : 2 * (j - 32) + 1); }
        case 5: { const int h = n >> 8, r = n & 255; return (r < 128) ? h * 128 + r : 1024 + h * 128 + (r - 128); }
        default: return n;
    }
}
constexpr int TR_LD = 68, TR_BYTES = 64 * TR_LD * 4;
__device__ __forceinline__ void tr_item(const float* W, int K, int N, bf16_t* WT, int kind, const float* gk, LAS float* scr, int item, int lane) {
    const int nblk = (N + 63) >> 6, kb = item / nblk, nb = item - kb * nblk, k0 = 64 * kb, n0 = 64 * nb;
    const int nn = n0 + 4 * (lane & 15); const bool ok = nn < N;
    f32x4 v[16];
#pragma unroll
    for (int i = 0; i < 16; ++i) { const int kk = 4 * i + (lane >> 4); v[i] = ok ? *(const f32x4*)(W + (size_t)(k0 + kk) * N + nn) : (f32x4){0.f, 0.f, 0.f, 0.f}; }
#pragma unroll
    for (int i = 0; i < 16; ++i) { const int kk = 4 * i + (lane >> 4); f32x4 x = v[i]; if (gk) x = x * gk[k0 + kk]; *(LAS f32x4*)(scr + kk * TR_LD + 4 * (lane & 15)) = x; }
    LDS_WAIT(); asm volatile("" ::: "memory");
    if (n0 + lane < N) {
        bf16_t* dst = WT + (size_t)map_row(kind, n0 + lane) * K + k0;
#pragma unroll
        for (int c = 0; c < 8; ++c) { const LAS float* sp = scr + (8 * c) * TR_LD + lane;
            u32x4 o; o.x = cvt_pk_bf16(sp[0 * TR_LD], sp[1 * TR_LD]); o.y = cvt_pk_bf16(sp[2 * TR_LD], sp[3 * TR_LD]); o.z = cvt_pk_bf16(sp[4 * TR_LD], sp[5 * TR_LD]); o.w = cvt_pk_bf16(sp[6 * TR_LD], sp[7 * TR_LD]);
            *(u32x4*)(dst + 8 * c) = o; }
    }
    LDS_WAIT(); asm volatile("" ::: "memory");
}

struct Args { const float* in[27]; float* out; unsigned char* ws; };

constexpr int AK_STRIDE = 400, AV_STRIDE = 144, AK_BUF = 64 * AK_STRIDE, AV_BUF = 128 * AV_STRIDE, AV_OFF = 2 * AK_BUF;
__device__ __forceinline__ void attn_unit(const bf16_t* QA, const bf16_t* KN, const bf16_t* P, const bf16_t* VT, bf16_t* HM, int b, int h, int qb, LAS unsigned char* lds, int tid, int wave, int lane) {
    const int tok0 = b * SEQ, q0 = qb * 256 + wave * 32, ql = lane & 31, hh = lane >> 5;
    bf16x8 qf[12];
    { const bf16_t* qp = QA + (size_t)(tok0 + q0 + ql) * 1536 + h * 192 + 8 * hh;
#pragma unroll
      for (int kb = 0; kb < 12; ++kb) qf[kb] = *(const bf16x8*)(qp + 16 * kb); }
    f32x16 o[4];
#pragma unroll
    for (int e = 0; e < 4; ++e)
#pragma unroll
        for (int r = 0; r < 16; ++r) o[e][r] = 0.f;
    float mrun = -1e30f, lrun = 0.f;
    const int ntiles = 4 * (qb + 1);
    const bf16_t* KNb = KN + (size_t)tok0 * 1024 + h * 128; const bf16_t* KRb = P + (size_t)tok0 * NIN + COL_KR; const bf16_t* VTb = VT + (size_t)(h * 128) * M + tok0;
    int ksrc[3], kdst[3], vsrc[2], vdst[2];
#pragma unroll
    for (int i = 0; i < 2; ++i) { const int c = tid + 512 * i, key = c >> 4, cc = c & 15; ksrc[i] = key * 1024 + 8 * cc; kdst[i] = key * AK_STRIDE + cc * 16; }
    { const int key = tid >> 3, cc = tid & 7; ksrc[2] = key * NIN + 8 * cc; kdst[2] = key * AK_STRIDE + (16 + cc) * 16; }
#pragma unroll
    for (int i = 0; i < 2; ++i) { const int c = tid + 512 * i, e = c >> 3, cc = c & 7; vsrc[i] = e * M + 8 * cc; vdst[i] = AV_OFF + e * AV_STRIDE + cc * 16; }
    u32x4 kr[3], vr[2];
#pragma unroll
    for (int i = 0; i < 3; ++i) kr[i] = *(const u32x4*)((i < 2 ? KNb : KRb) + ksrc[i]);
#pragma unroll
    for (int i = 0; i < 2; ++i) vr[i] = *(const u32x4*)(VTb + vsrc[i]);
#pragma unroll
    for (int i = 0; i < 3; ++i) *(LAS u32x4*)(lds + kdst[i]) = kr[i];
#pragma unroll
    for (int i = 0; i < 2; ++i) *(LAS u32x4*)(lds + vdst[i]) = vr[i];
    __syncthreads();
    for (int kt = 0; kt < ntiles; ++kt) {
        const int cur = kt & 1;
        const bool more = (kt + 1 < ntiles);
        if (more) {
#pragma unroll
            for (int i = 0; i < 3; ++i) kr[i] = *(const u32x4*)((i < 2 ? KNb + (size_t)(kt + 1) * 65536 : KRb + (size_t)(kt + 1) * (64 * NIN)) + ksrc[i]);
#pragma unroll
            for (int i = 0; i < 2; ++i) vr[i] = *(const u32x4*)(VTb + (kt + 1) * 64 + vsrc[i]);
        }
        if (kt * 64 <= q0 + 31) {
            const LAS unsigned char* kb_ = lds + cur * AK_BUF;
            const LAS unsigned char* vb_ = lds + AV_OFF + cur * AV_BUF;
            f32x16 st[2];
#pragma unroll
            for (int t = 0; t < 2; ++t) {
#pragma unroll
                for (int r = 0; r < 16; ++r) st[t][r] = 0.f;
#pragma unroll
                for (int kb = 0; kb < 12; ++kb) {
                    const bf16x8 a = *(const LAS bf16x8*)(kb_ + (32 * t + ql) * AK_STRIDE + (16 * kb + 8 * hh) * 2);
                    st[t] = __builtin_amdgcn_mfma_f32_32x32x16_bf16(a, qf[kb], st[t], 0, 0, 0);
                }
            }
            if (kt * 64 + 63 > q0) {
                const int qpos = q0 + ql;
#pragma unroll
                for (int t = 0; t < 2; ++t)
#pragma unroll
                    for (int r = 0; r < 16; ++r) { const int key = kt * 64 + 32 * t + (r & 3) + 8 * (r >> 2) + 4 * hh; if (key > qpos) st[t][r] = -1e30f; }
            }
            float mx = -1e30f;
#pragma unroll
            for (int t = 0; t < 2; ++t)
#pragma unroll
                for (int r = 0; r < 16; ++r) mx = fmaxf(mx, st[t][r]);
            mx = fmaxf(mx, __shfl_xor(mx, 32));
            const float mnew = fmaxf(mrun, mx), alpha = __builtin_amdgcn_exp2f(mrun - mnew);
            float rs = 0.f;
#pragma unroll
            for (int t = 0; t < 2; ++t)
#pragma unroll
                for (int r = 0; r < 16; ++r) { const float p = __builtin_amdgcn_exp2f(st[t][r] - mnew); st[t][r] = p; rs += p; }
            rs += __shfl_xor(rs, 32);
            lrun = lrun * alpha + rs; mrun = mnew;
#pragma unroll
            for (int e = 0; e < 4; ++e)
#pragma unroll
                for (int r = 0; r < 16; ++r) o[e][r] *= alpha;
#pragma unroll
            for (int t = 0; t < 2; ++t) {
                bf16x8 pb[2];
#pragma unroll
                for (int kb = 0; kb < 2; ++kb) {
                    u32x4 w;
                    w.x = cvt_pk_bf16(st[t][8 * kb + 0], st[t][8 * kb + 1]); w.y = cvt_pk_bf16(st[t][8 * kb + 2], st[t][8 * kb + 3]);
                    w.z = cvt_pk_bf16(st[t][8 * kb + 4], st[t][8 * kb + 5]); w.w = cvt_pk_bf16(st[t][8 * kb + 6], st[t][8 * kb + 7]);
                    pb[kb] = __builtin_bit_cast(bf16x8, w);
                }
#pragma unroll
                for (int e = 0; e < 4; ++e)
#pragma unroll
                    for (int kb = 0; kb < 2; ++kb) {
                        const LAS unsigned char* vp = vb_ + (32 * e + ql) * AV_STRIDE + (16 * (2 * t + kb) + 4 * hh) * 2;
                        const u32x2 lo = *(const LAS u32x2*)vp, hi = *(const LAS u32x2*)(vp + 16);
                        const u32x4 av = {lo.x, lo.y, hi.x, hi.y};
                        o[e] = __builtin_amdgcn_mfma_f32_32x32x16_bf16(__builtin_bit_cast(bf16x8, av), pb[kb], o[e], 0, 0, 0);
                    }
            }
        }
        if (more) {
            LAS unsigned char* kw = lds + (cur ^ 1) * AK_BUF; LAS unsigned char* vw = lds + (cur ^ 1) * AV_BUF;
#pragma unroll
            for (int i = 0; i < 3; ++i) *(LAS u32x4*)(kw + kdst[i]) = kr[i];
#pragma unroll
            for (int i = 0; i < 2; ++i) *(LAS u32x4*)(vw + vdst[i]) = vr[i];
        }
        __syncthreads();
    }
    const float inv = 1.0f / lrun;
    bf16_t* op = HM + (size_t)(tok0 + q0 + ql) * D + 1024 + h * 128 + 4 * hh;
#pragma unroll
    for (int e = 0; e < 4; ++e)
#pragma unroll
        for (int g = 0; g < 4; ++g) {
            u32x2 w; w.x = cvt_pk_bf16(o[e][4 * g + 0] * inv, o[e][4 * g + 1] * inv); w.y = cvt_pk_bf16(o[e][4 * g + 2] * inv, o[e][4 * g + 3] * inv);
            *(u32x2*)(op + 32 * e + 8 * g) = w;
        }
}

constexpr int MK_STRIDE = 272, MK_BUF = 64 * MK_STRIDE, MV_OFF = 2 * MK_BUF, ME_OFF = MV_OFF + 2 * AV_BUF;
__device__ __forceinline__ void mlp_unit(const bf16_t* QC, const bf16_t* KC, const bf16_t* VTM, const float* EG, const float* MG, float* HRAW, int b, int h, int qb, int eh, LAS unsigned char* lds, int tid, int wave, int lane) {
    const int tok0 = b * SEQ, q0 = qb * 256 + wave * 32, ql = lane & 31, hh = lane >> 5, bh = b * 4 + h;
    bf16x8 qf[8];
    { const bf16_t* qp = QC + (size_t)(tok0 + q0 + ql) * 512 + h * 128 + 8 * hh;
#pragma unroll
      for (int kb = 0; kb < 8; ++kb) qf[kb] = *(const bf16x8*)(qp + 16 * kb); }
    const float mg = MG[bh * SEQ + q0 + ql];
    f32x16 o[4];
#pragma unroll
    for (int e = 0; e < 4; ++e)
#pragma unroll
        for (int r = 0; r < 16; ++r) o[e][r] = 0.f;
    const int ntiles = 4 * (qb + 1);
    const bf16_t* KCb = KC + (size_t)tok0 * 512 + h * 128; const bf16_t* VTb = VTM + (size_t)(h * 256 + eh * 128) * M + tok0; const float* EGb = EG + bh * SEQ;
    int ksrc[2], kdst[2], vsrc[2], vdst[2];
#pragma unroll
    for (int i = 0; i < 2; ++i) { const int c = tid + 512 * i, key = c >> 4, cc = c & 15; ksrc[i] = key * 512 + 8 * cc; kdst[i] = key * MK_STRIDE + cc * 16; }
#pragma unroll
    for (int i = 0; i < 2; ++i) { const int c = tid + 512 * i, e = c >> 3, cc = c & 7; vsrc[i] = e * M + 8 * cc; vdst[i] = MV_OFF + e * AV_STRIDE + cc * 16; }
    u32x4 kr[2], vr[2]; float er = 0.f;
#pragma unroll
    for (int i = 0; i < 2; ++i) kr[i] = *(const u32x4*)(KCb + ksrc[i]);
#pragma unroll
    for (int i = 0; i < 2; ++i) vr[i] = *(const u32x4*)(VTb + vsrc[i]);
    if (tid < 64) er = EGb[tid];
#pragma unroll
    for (int i = 0; i < 2; ++i) *(LAS u32x4*)(lds + kdst[i]) = kr[i];
#pragma unroll
    for (int i = 0; i < 2; ++i) *(LAS u32x4*)(lds + vdst[i]) = vr[i];
    if (tid < 64) *(LAS float*)(lds + ME_OFF + 4 * tid) = er;
    __syncthreads();
    for (int kt = 0; kt < ntiles; ++kt) {
        const int cur = kt & 1;
        const bool more = (kt + 1 < ntiles);
        if (more) {
#pragma unroll
            for (int i = 0; i < 2; ++i) kr[i] = *(const u32x4*)(KCb + (size_t)(kt + 1) * (64 * 512) + ksrc[i]);
#pragma unroll
            for (int i = 0; i < 2; ++i) vr[i] = *(const u32x4*)(VTb + (kt + 1) * 64 + vsrc[i]);
            if (tid < 64) er = EGb[(kt + 1) * 64 + tid];
        }
        if (kt * 64 <= q0 + 31) {
            const LAS unsigned char* kb_ = lds + cur * MK_BUF;
            const LAS unsigned char* vb_ = lds + MV_OFF + cur * AV_BUF;
            const LAS unsigned char* eb_ = lds + ME_OFF + cur * 256;
            const int qpos = q0 + ql;
#pragma unroll
            for (int t = 0; t < 2; ++t) {
                f32x16 st;
#pragma unroll
                for (int r = 0; r < 16; ++r) st[r] = 0.f;
#pragma unroll
                for (int kb = 0; kb < 8; ++kb) {
                    const bf16x8 a = *(const LAS bf16x8*)(kb_ + (32 * t + ql) * MK_STRIDE + (16 * kb + 8 * hh) * 2);
                    st = __builtin_amdgcn_mfma_f32_32x32x16_bf16(a, qf[kb], st, 0, 0, 0);
                }
#pragma unroll
                for (int g = 0; g < 4; ++g) {
                    const f32x4 ev = *(const LAS f32x4*)(eb_ + 4 * (32 * t + 8 * g + 4 * hh));
#pragma unroll
                    for (int i = 0; i < 4; ++i) {
                        const int key = kt * 64 + 32 * t + 8 * g + 4 * hh + i;
                        const float w = __builtin_amdgcn_exp2f(fminf(ev[i] - mg, 0.f));
                        st[4 * g + i] = (key <= qpos) ? st[4 * g + i] * w : 0.f;
                    }
                }
                bf16x8 pb[2];
#pragma unroll
                for (int kb = 0; kb < 2; ++kb) {
                    u32x4 w;
                    w.x = cvt_pk_bf16(st[8 * kb + 0], st[8 * kb + 1]); w.y = cvt_pk_bf16(st[8 * kb + 2], st[8 * kb + 3]);
                    w.z = cvt_pk_bf16(st[8 * kb + 4], st[8 * kb + 5]); w.w = cvt_pk_bf16(st[8 * kb + 6], st[8 * kb + 7]);
                    pb[kb] = __builtin_bit_cast(bf16x8, w);
                }
#pragma unroll
                for (int e = 0; e < 4; ++e)
#pragma unroll
                    for (int kb = 0; kb < 2; ++kb) {
                        const LAS unsigned char* vp = vb_ + (32 * e + ql) * AV_STRIDE + (16 * (2 * t + kb) + 4 * hh) * 2;
                        const u32x2 lo = *(const LAS u32x2*)vp, hi = *(const LAS u32x2*)(vp + 16);
                        const u32x4 av = {lo.x, lo.y, hi.x, hi.y};
                        o[e] = __builtin_amdgcn_mfma_f32_32x32x16_bf16(__builtin_bit_cast(bf16x8, av), pb[kb], o[e], 0, 0, 0);
                    }
            }
        }
        if (more) {
            LAS unsigned char* kw = lds + (cur ^ 1) * MK_BUF; LAS unsigned char* vw = lds + (cur ^ 1) * AV_BUF;
#pragma unroll
            for (int i = 0; i < 2; ++i) *(LAS u32x4*)(kw + kdst[i]) = kr[i];
#pragma unroll
            for (int i = 0; i < 2; ++i) *(LAS u32x4*)(vw + vdst[i]) = vr[i];
            if (tid < 64) *(LAS float*)(lds + ME_OFF + (cur ^ 1) * 256 + 4 * tid) = er;
        }
        __syncthreads();
    }
    float* op = HRAW + (size_t)(tok0 + q0 + ql) * 1024 + h * 256 + eh * 128 + 4 * hh;
#pragma unroll
    for (int e = 0; e < 4; ++e)
#pragma unroll
        for (int g = 0; g < 4; ++g) {
            const f32x4 w = {o[e][4 * g + 0], o[e][4 * g + 1], o[e][4 * g + 2], o[e][4 * g + 3]};
            *(f32x4*)(op + 32 * e + 8 * g) = w;
        }
}

__global__ void __launch_bounds__(512, 2) fwd_kernel(Args args) {
    extern __shared__ __attribute__((aligned(16))) unsigned char lds_raw[];
    LAS unsigned char* lds = (LAS unsigned char*)lds_raw;
    cg::grid_group grid = cg::this_grid();
    const int G = gridDim.x, bid = blockIdx.x, NGW = G * 8;
    volatile LAS unsigned* bst = (volatile LAS unsigned*)(lds + LDS_BYTES - 16);
    if (threadIdx.x < 4) bst[threadIdx.x] = 0u;
    __syncthreads();
    const XcdBarrier xbar = xcd_barrier_post((unsigned*)args.ws, bst);
#define GRID_SYNC_CG() do { asm volatile("s_waitcnt vmcnt(0)" ::: "memory"); __syncthreads(); grid.sync(); } while (0)
#define GRID_SYNC() xcd_barrier(xbar)
#define PH_THREAD() const int tid = opaque_tid(), lane = tid & 63, wave = __builtin_amdgcn_readfirstlane(tid >> 6), gw = bid * 8 + wave; (void)lane; (void)gw; (void)tid
    unsigned char* ws = args.ws;
    const float* x_in = args.in[0];
    float* MOD = (float*)(ws + WS_MOD); f32x2* ROPE = (f32x2*)(ws + WS_ROPE); float* GATES = (float*)(ws + WS_GATES);
    bf16_t* U = (bf16_t*)(ws + WS_U); float* Z = (float*)(ws + WS_Z); float* X = (float*)(ws + WS_X);
    bf16_t* Hb = (bf16_t*)(ws + WS_H); bf16_t* P = (bf16_t*)(ws + WS_P); bf16_t* QA = (bf16_t*)(ws + WS_QA); bf16_t* KN = (bf16_t*)(ws + WS_KN);
    bf16_t* VT = (bf16_t*)(ws + WS_VT); bf16_t* HM = (bf16_t*)(ws + WS_HM); float* HRAW = (float*)(ws + WS_HRAW);
    bf16_t* QC = (bf16_t*)(ws + WS_QC); bf16_t* KC = (bf16_t*)(ws + WS_KC); bf16_t* VTM = (bf16_t*)(ws + WS_VTM); float* EG = (float*)(ws + WS_EG); float* MG = (float*)(ws + WS_MG);

    for (int rep_ = 0; rep_ < ((0 == DBG_REP_PH) ? 2 : 1); ++rep_) { constexpr int ph = 0; PH_THREAD(); if (rep_) { asm volatile("s_waitcnt vmcnt(0)" ::: "memory"); __syncthreads(); }
            for (int rs_ = 0; rs_ < ((DBG_REP_SUB == 1) ? 2 : 1); ++rs_)
            if (bid < 144) {
                LAS float* sc = (LAS float*)lds; LAS float* red = sc + 8192;
                const float* c = args.in[1]; const float* w_ada = args.in[2]; const float* b_ada = args.in[3];
                for (int i = tid; i < 8192; i += 512) { const float v = c[i]; sc[i] = v / (1.f + expf(-v)); }
                __syncthreads();
                const int col = bid * 128 + 2 * lane;
                float a[4][2];
#pragma unroll
                for (int b = 0; b < 4; ++b) { a[b][0] = 0.f; a[b][1] = 0.f; }
                const float* wp = w_ada + (size_t)(256 * wave) * NMOD + col;
#pragma unroll 16
                for (int k = 0; k < 256; ++k) {
                    const f32x2 v = *(const f32x2*)(wp + (size_t)k * NMOD);
#pragma unroll
                    for (int b = 0; b < 4; ++b) { const float s = sc[b * 2048 + 256 * wave + k]; a[b][0] += s * v.x; a[b][1] += s * v.y; }
                }
#pragma unroll
                for (int b = 0; b < 4; ++b) { red[(wave * 4 + b) * 128 + 2 * lane] = a[b][0]; red[(wave * 4 + b) * 128 + 2 * lane + 1] = a[b][1]; }
                __syncthreads();
                { const int b = tid >> 7, cc = tid & 127; float s = b_ada[bid * 128 + cc];
#pragma unroll
                  for (int w = 0; w < 8; ++w) s += red[(w * 4 + b) * 128 + cc];
                  MOD[(size_t)b * NMOD + bid * 128 + cc] = s; }
                __syncthreads();
            }
            for (int i = bid * 512 + tid; i < SEQ * 32; i += G * 512) {
                const int s = i >> 5, j = i & 31;
                const float inv = (float)pow(10000.0, -(double)j / 32.0);
                const float ang = (float)s * inv;
                const double rev = (double)ang * 0.15915494309189535; const float fr_ = (float)(rev - rint(rev));
                ROPE[i] = (f32x2){__builtin_amdgcn_cosf(fr_), __builtin_amdgcn_sinf(fr_)};
            }
            __syncthreads();
            LAS float* scr = (LAS float*)(lds + wave * TR_BYTES);
            constexpr int I_UP = 32 * 88, I_DN = 88 * 32, I_IN = 32 * 62, I_UQ = 8 * 24, I_KV = 4 * 32, I_WO = 32 * 32;
            constexpr int NIT = 4 * I_UP + 2 * I_DN + I_IN + I_UQ + I_KV + I_WO;
            static_assert(NIT == 1152 * 9 + 896 * 11, "item split between adaLN blocks and the rest");
            int it0, itn, its;
            if (G == 256) { if (bid < 144) { it0 = gw; its = 1152; itn = 1152 * 9; } else { it0 = 1152 * 9 + (gw - 1152); its = 896; itn = NIT; } }
            else { it0 = gw; its = NGW; itn = NIT; }
            for (int rs_ = 0; rs_ < ((DBG_REP_SUB == 2) ? 2 : 1); ++rs_)
            for (int it = it0; it < itn; it += its) {
                int r = it;
                if (r < I_UP) { tr_item(args.in[4], D, FF, (bf16_t*)(ws + WS_W13A), 0, nullptr, scr, r, lane); continue; } r -= I_UP;
                if (r < I_UP) { tr_item(args.in[5], D, FF, (bf16_t*)(ws + WS_W13A), 1, nullptr, scr, r, lane); continue; } r -= I_UP;
                if (r < I_DN) { tr_item(args.in[6], FF, D, (bf16_t*)(ws + WS_W2A), 2, nullptr, scr, r, lane); continue; } r -= I_DN;
                if (r < I_IN) { tr_item(args.in[9], D, DIN, (bf16_t*)(ws + WS_WIN), 3, nullptr, scr, r, lane); continue; } r -= I_IN;
                if (r < I_UQ) { tr_item(args.in[16], 512, 1536, (bf16_t*)(ws + WS_WUQ), 4, args.in[15], scr, r, lane); continue; } r -= I_UQ;
                if (r < I_KV) { tr_item(args.in[18], 256, 2048, (bf16_t*)(ws + WS_WK), 5, args.in[17], scr, r, lane); continue; } r -= I_KV;
                if (r < I_WO) { tr_item(args.in[19], D, D, (bf16_t*)(ws + WS_WOUT), 2, nullptr, scr, r, lane); continue; } r -= I_WO;
                if (r < I_UP) { tr_item(args.in[22], D, FF, (bf16_t*)(ws + WS_W13B), 0, nullptr, scr, r, lane); continue; } r -= I_UP;
                if (r < I_UP) { tr_item(args.in[23], D, FF, (bf16_t*)(ws + WS_W13B), 1, nullptr, scr, r, lane); continue; } r -= I_UP;
                tr_item(args.in[24], FF, D, (bf16_t*)(ws + WS_W2B), 2, nullptr, scr, r, lane);
            }
    }
    GRID_SYNC_CG();
    for (int rep_ = 0; rep_ < ((1 == DBG_REP_PH) ? 2 : 1); ++rep_) { constexpr int ph = 1; PH_THREAD(); if (rep_) { asm volatile("s_waitcnt vmcnt(0)" ::: "memory"); __syncthreads(); }
            for (int row = gw; row < M; row += NGW) {
                const int b = row >> 11; const float* mb = MOD + (size_t)b * NMOD;
                const f32x4* xr = (const f32x4*)(x_in + (size_t)row * D) + lane; u32x2* ur = (u32x2*)(U + (size_t)row * D) + lane;
#pragma unroll
                for (int j = 0; j < 8; ++j) { const f32x4 v = xr[64 * j]; const f32x4 sh = *((const f32x4*)mb + lane + 64 * j), scl = *((const f32x4*)(mb + 2048) + lane + 64 * j);
                    const f32x4 y = v * (scl + 1.0f) + sh; u32x2 w; w.x = cvt_pk_bf16(y[0], y[1]); w.y = cvt_pk_bf16(y[2], y[3]); ur[64 * j] = w; }
            }
            }
    GRID_SYNC();
#if DBG_XSYNC
    for (int xs_ = 0; xs_ < DBG_XSYNC; ++xs_) GRID_SYNC();
#endif
    for (int rep_ = 0; rep_ < ((2 == DBG_REP_PH) ? 2 : 1); ++rep_) { constexpr int ph = 2; PH_THREAD(); if (rep_) { asm volatile("s_waitcnt vmcnt(0)" ::: "memory"); __syncthreads(); }
            const bf16_t* Wt = (const bf16_t*)(ws + (ph == 2 ? WS_W13A : WS_W13B));
            pg8::Gemm g{U, Wt, D, D, D}; pg8::StaticOrder S; S.init(M, 2 * FF, G, bid);
            pg8::EpiSwiglu E{Hb};
            pg8::gemm_phase<pg8::EpiSwiglu, pg8::StaticOrder, true>(lds, g, S, E);
            }
    GRID_SYNC();
    for (int rep_ = 0; rep_ < ((3 == DBG_REP_PH) ? 2 : 1); ++rep_) { constexpr int ph = 3; PH_THREAD(); if (rep_) { asm volatile("s_waitcnt vmcnt(0)" ::: "memory"); __syncthreads(); }
            const int s = (ph == 3) ? 0 : (ph == 9 ? 1 : 2);
            const bf16_t* A = (ph == 9) ? HM : Hb; const bf16_t* Wt = (const bf16_t*)(ws + (ph == 3 ? WS_W2A : (ph == 9 ? WS_WOUT : WS_W2B)));
            const int K = (ph == 9) ? D : FF;
            const float* Xr = (ph == 3) ? x_in : X;
            pg8::Gemm g{A, Wt, K, K, K}; pg8::StaticOrder S; S.init(M, D, G, bid);
            pg8::EpiResid E{Xr, Z, MOD + s * 6144 + 4096, (ph == 9) ? 1.0f : 0.5f};
            pg8::gemm_phase<pg8::EpiResid, pg8::StaticOrder, true>(lds, g, S, E);
            }
    GRID_SYNC();
    for (int rep_ = 0; rep_ < ((4 == DBG_REP_PH) ? 2 : 1); ++rep_) { constexpr int ph = 4; PH_THREAD(); if (rep_) { asm volatile("s_waitcnt vmcnt(0)" ::: "memory"); __syncthreads(); }
            const int s = (ph == 4) ? 1 : 2;
            const float* gp = args.in[ph == 4 ? 7 : (ph == 10 ? 20 : 25)]; const float* bp = args.in[ph == 4 ? 8 : (ph == 10 ? 21 : 26)];
            float* Xo = (ph == 13) ? args.out : X;
            for (int row = gw; row < M; row += NGW) {
                const int b = row >> 11; const float* mb = MOD + (size_t)b * NMOD + s * 6144;
                const f32x4* zr = (const f32x4*)(Z + (size_t)row * D) + lane;
                f32x4 v[8]; float sm = 0.f;
#pragma unroll
                for (int j = 0; j < 8; ++j) { v[j] = zr[64 * j]; sm += (v[j][0] + v[j][1]) + (v[j][2] + v[j][3]); }
                const float mean = wave_sum(sm) * (1.f / D); float s2 = 0.f;
#pragma unroll
                for (int j = 0; j < 8; ++j) { v[j] = v[j] - mean; s2 += (v[j][0] * v[j][0] + v[j][1] * v[j][1]) + (v[j][2] * v[j][2] + v[j][3] * v[j][3]); }
                const float rstd = 1.f / sqrtf(wave_sum(s2) * (1.f / D) + LN_EPS);
                f32x4* xo = (f32x4*)(Xo + (size_t)row * D) + lane; u32x2* ur = (u32x2*)(U + (size_t)row * D) + lane;
#pragma unroll
                for (int j = 0; j < 8; ++j) {
                    const f32x4 gg = *((const f32x4*)gp + lane + 64 * j), bb = *((const f32x4*)bp + lane + 64 * j);
                    const f32x4 y = v[j] * rstd * gg + bb; xo[64 * j] = y;
                    if (ph != 13) { const f32x4 sh = *((const f32x4*)mb + lane + 64 * j), scl = *((const f32x4*)(mb + 2048) + lane + 64 * j);
                        const f32x4 uu = y * (scl + 1.0f) + sh; u32x2 w; w.x = cvt_pk_bf16(uu[0], uu[1]); w.y = cvt_pk_bf16(uu[2], uu[3]); ur[64 * j] = w; }
                }
            }
            }
    GRID_SYNC();
    for (int rep_ = 0; rep_ < ((5 == DBG_REP_PH) ? 2 : 1); ++rep_) { constexpr int ph = 5; PH_THREAD(); if (rep_) { asm volatile("s_waitcnt vmcnt(0)" ::: "memory"); __syncthreads(); }
            pg8::Gemm g{U, (const bf16_t*)(ws + WS_WIN), D, D, D}; pg8::StaticOrder S; S.init(M, NIN, G, bid);
            pg8::EpiWin E{P, GATES, ROPE};
            pg8::gemm_phase<pg8::EpiWin, pg8::StaticOrder, true>(lds, g, S, E);
            }
    GRID_SYNC();
    for (int rep_ = 0; rep_ < ((6 == DBG_REP_PH) ? 2 : 1); ++rep_) { constexpr int ph = 6; PH_THREAD(); if (rep_) { asm volatile("s_waitcnt vmcnt(0)" ::: "memory"); __syncthreads(); }
            LAS float* tab = (LAS float*)(lds + TAB_OFF);
            for (int rs_ = 0; rs_ < ((DBG_REP_SUB == 3) ? 2 : 1); ++rs_)
            for (int L = bid; L < 448; L += G) {
                int mode, pm, pn;
                if (L < 192) { mode = 0; pm = L / 6; pn = L % 6; } else if (L < 320) { mode = 1; pm = (L - 192) >> 2; pn = (L - 192) & 3; } else { mode = 2; pm = (L - 320) & 3; pn = (L - 320) >> 2; }
                const int t0 = ((mode == 2) ? pn : pm) * 256;
                __syncthreads();
#pragma unroll
                for (int rb = 0; rb < 32; rb += 8) {
                    u32x4 wq[8];
#pragma unroll
                    for (int r = 0; r < 8; ++r) {
                        const bf16_t* pr = P + (size_t)(t0 + 32 * wave + rb + r) * NIN;
                        if (mode == 0) wq[r] = *(const u32x4*)(pr + COL_CQ + 8 * lane);
                        else { const u32x2 w2 = *(const u32x2*)(pr + COL_CKV + 4 * lane); wq[r] = (u32x4){w2.x, w2.y, 0u, 0u}; }
                    }
#pragma unroll
                    for (int r = 0; r < 8; ++r) {
                        const u32x4 w = wq[r]; const float a0 = bflo(w.x), a1 = bfhi(w.x), a2 = bflo(w.y), a3 = bfhi(w.y), a4 = bflo(w.z), a5 = bfhi(w.z), a6 = bflo(w.w), a7 = bfhi(w.w);
                        float ss = (a0 * a0 + a1 * a1) + (a2 * a2 + a3 * a3) + (a4 * a4 + a5 * a5) + (a6 * a6 + a7 * a7);
                        ss = wave_sum(ss);
                        if (lane == 0) tab[32 * wave + rb + r] = 1.f / sqrtf(ss * (mode == 0 ? 1.f / 512.f : 1.f / 256.f) + LN_EPS);
                    }
                }
                __syncthreads();
                pg8::Gemm g;
                if (mode == 0) g = pg8::Gemm{P + COL_CQ, (const bf16_t*)(ws + WS_WUQ), NIN, 512, 512};
                else if (mode == 1) g = pg8::Gemm{P + COL_CKV, (const bf16_t*)(ws + WS_WK), NIN, 256, 256};
                else g = pg8::Gemm{(const bf16_t*)(ws + WS_WV), P + COL_CKV, 256, NIN, 256};
                pg8::SingleUnit S; S.u0.pm = pm; S.u0.pn = pn;
                pg8::EpiLR E{mode, mode == 0 ? QA : (mode == 1 ? KN : VT), mode == 0 ? 1536 : (mode == 1 ? 1024 : M), tab, ROPE};
                pg8::gemm_phase<pg8::EpiLR, pg8::SingleUnit, false>(lds, g, S, E);
            }
            __syncthreads();
            for (int rs_ = 0; rs_ < ((DBG_REP_SUB == 4) ? 2 : 1); ++rs_)
            {
                const float* conv_w = args.in[10]; const float* conv_b = args.in[11];
                {
                    const int cgp = tid & 127, ch0 = 8 * cgp;
                    float cwr[5][8];
#pragma unroll
                    for (int j = 0; j < 4; ++j)
#pragma unroll
                        for (int i = 0; i < 8; ++i) cwr[j][i] = conv_w[j * 1024 + ch0 + i];
#pragma unroll
                    for (int i = 0; i < 8; ++i) cwr[4][i] = conv_b[ch0 + i];
                    const float ksc = (ch0 < 512) ? 1.0f : 0.08838834764831845f;
                    bf16_t* dstb = (ch0 < 512) ? QC + ch0 : KC + (ch0 - 512);
                    for (int row = bid * 4 + (tid >> 7); row < M; row += G * 4) {
                        const int sq = row & (SEQ - 1);
                        u32x4 xr[4];
#pragma unroll
                        for (int r = 0; r < 4; ++r) xr[r] = (sq - 3 + r >= 0) ? *(const u32x4*)(P + (size_t)(row - 3 + r) * NIN + ch0) : (u32x4){0u, 0u, 0u, 0u};
                        unsigned ow[4];
#pragma unroll
                        for (int wd = 0; wd < 4; ++wd) {
                            float a0 = cwr[4][2 * wd], a1 = cwr[4][2 * wd + 1];
#pragma unroll
                            for (int r = 0; r < 4; ++r) { const unsigned w = (wd == 0) ? xr[r].x : (wd == 1) ? xr[r].y : (wd == 2) ? xr[r].z : xr[r].w; a0 += cwr[r][2 * wd] * bflo(w); a1 += cwr[r][2 * wd + 1] * bfhi(w); }
                            ow[wd] = cvt_pk_bf16(silu_f(a0) * ksc, silu_f(a1) * ksc);
                        }
                        *(u32x4*)(dstb + (size_t)row * 512) = (u32x4){ow[0], ow[1], ow[2], ow[3]};
                    }
                }
                LAS unsigned char* tl = lds + wave * 9216;
                for (int tix = gw; tix < 128 * 16; tix += NGW) {
                    const int tt = tix >> 4, et = tix & 15;
#pragma unroll
                    for (int c = 0; c < 8; ++c) {
                        const u32x4 v = *(const u32x4*)(P + (size_t)(tt * 64 + lane) * NIN + 1024 + et * 64 + 8 * c);
                        const unsigned wv[4] = {v.x, v.y, v.z, v.w};
#pragma unroll
                        for (int i = 0; i < 4; ++i) { *(LAS bf16_t*)(tl + (8 * c + 2 * i) * 144 + 2 * lane) = (bf16_t)(wv[i] & 0xffffu); *(LAS bf16_t*)(tl + (8 * c + 2 * i + 1) * 144 + 2 * lane) = (bf16_t)(wv[i] >> 16); }
                    }
                    LDS_WAIT(); asm volatile("" ::: "memory");
#pragma unroll
                    for (int c = 0; c < 8; ++c) { const u32x4 v = *(const LAS u32x4*)(tl + lane * 144 + 16 * c); *(u32x4*)(VTM + (size_t)(et * 64 + lane) * M + tt * 64 + 8 * c) = v; }
                    LDS_WAIT(); asm volatile("" ::: "memory");
                }
                if (gw < 16) {
                    const int b = gw >> 2, h = gw & 3; const float big = args.in[12][h], bfg = args.in[13][h];
                    const float* gp = GATES + (size_t)(b * SEQ + 32 * lane) * 8;
                    float ev[32], cv[32];
#pragma unroll
                    for (int i = 0; i < 32; ++i) { ev[i] = gp[i * 8 + h] + big; const float fp = gp[i * 8 + 4 + h] + bfg; cv[i] = fminf(fp, 0.f) - log1pf(__expf(-fabsf(fp))); }
#pragma unroll
                    for (int i = 1; i < 32; ++i) cv[i] += cv[i - 1];
                    float tot = cv[31], inc = tot;
#pragma unroll
                    for (int d = 1; d < 64; d <<= 1) { const float t = __shfl_up(inc, d); if (lane >= d) inc += t; }
                    const float off = inc - tot;
#pragma unroll
                    for (int i = 0; i < 32; ++i) ev[i] = (ev[i] - (cv[i] + off)) * 1.4426950408889634f;
#pragma unroll
                    for (int i = 0; i < 32; ++i) cv[i] = (i == 0) ? ev[0] : fmaxf(cv[i - 1], ev[i]);
                    float mx = cv[31];
#pragma unroll
                    for (int d = 1; d < 64; d <<= 1) { const float t = __shfl_up(mx, d); if (lane >= d) mx = fmaxf(mx, t); }
                    float mo = __shfl_up(mx, 1); if (lane == 0) mo = -1e30f;
                    float* eo = EG + gw * SEQ + 32 * lane; float* mo_ = MG + gw * SEQ + 32 * lane;
#pragma unroll
                    for (int i = 0; i < 32; i += 4) {
                        *(f32x4*)(eo + i) = (f32x4){ev[i], ev[i + 1], ev[i + 2], ev[i + 3]};
                        *(f32x4*)(mo_ + i) = (f32x4){fmaxf(cv[i], mo), fmaxf(cv[i + 1], mo), fmaxf(cv[i + 2], mo), fmaxf(cv[i + 3], mo)};
                    }
                }
            }
    }
    GRID_SYNC();
    for (int rep_ = 0; rep_ < ((7 == DBG_REP_PH) ? 2 : 1); ++rep_) { constexpr int ph = 7; PH_THREAD(); if (rep_) { asm volatile("s_waitcnt vmcnt(0)" ::: "memory"); __syncthreads(); }
#if !DBG_NO_MLSTM
            for (int it = bid; it < 128; it += G) {
                const int bh = it >> 3, eh = (it >> 2) & 1, pr = it & 3;
                mlp_unit(QC, KC, VTM, EG, MG, HRAW, bh >> 2, bh & 3, 7 - pr, eh, lds, tid, wave, lane);
                mlp_unit(QC, KC, VTM, EG, MG, HRAW, bh >> 2, bh & 3, pr, eh, lds, tid, wave, lane);
#if DBG_MIX2 & 1
                mlp_unit(QC, KC, VTM, EG, MG, HRAW, bh >> 2, bh & 3, 7 - pr, eh, lds, tid, wave, lane);
                mlp_unit(QC, KC, VTM, EG, MG, HRAW, bh >> 2, bh & 3, pr, eh, lds, tid, wave, lane);
#endif
            }
#endif
#if !DBG_NO_ATTN
            for (int it = bid; it < 256; it += G) {
                if (it < 128) continue;
                const int a = it - 128, bh = a >> 2, pr = a & 3;
                attn_unit(QA, KN, P, VT, HM, bh >> 3, bh & 7, 7 - pr, lds, tid, wave, lane);
                attn_unit(QA, KN, P, VT, HM, bh >> 3, bh & 7, pr, lds, tid, wave, lane);
#if DBG_MIX2 & 2
                attn_unit(QA, KN, P, VT, HM, bh >> 3, bh & 7, 7 - pr, lds, tid, wave, lane);
                attn_unit(QA, KN, P, VT, HM, bh >> 3, bh & 7, pr, lds, tid, wave, lane);
#endif
            }
#endif
    }
    GRID_SYNC();
    for (int rep_ = 0; rep_ < ((8 == DBG_REP_PH) ? 2 : 1); ++rep_) { constexpr int ph = 8; PH_THREAD(); if (rep_) { asm volatile("s_waitcnt vmcnt(0)" ::: "memory"); __syncthreads(); }
            const float* mg = args.in[14];
            for (int row = gw; row < M; row += NGW) {
#pragma unroll
                for (int hh = 0; hh < 4; ++hh) {
#if DBG_NO_MLSTM
                    f32x4 v = {0.f, 0.f, 0.f, 0.f};
#else
                    f32x4 v = *((const f32x4*)(HRAW + (size_t)row * 1024 + hh * 256) + lane);
#endif
                    const float mean = wave_sum((v[0] + v[1]) + (v[2] + v[3])) * (1.f / 256.f);
                    v = v - mean;
                    const float rstd = 1.f / sqrtf(wave_sum((v[0] * v[0] + v[1] * v[1]) + (v[2] * v[2] + v[3] * v[3])) * (1.f / 256.f) + LN_EPS);
                    const f32x4 gg = *((const f32x4*)(mg + hh * 256) + lane);
                    const u32x2 ow = *((const u32x2*)(P + (size_t)row * NIN + 2048 + hh * 256) + lane);
                    const float o0 = bflo(ow.x), o1 = bfhi(ow.x), o2 = bflo(ow.y), o3 = bfhi(ow.y);
                    f32x4 y = v * rstd * gg;
                    y[0] *= 1.f / (1.f + __expf(-o0)); y[1] *= 1.f / (1.f + __expf(-o1)); y[2] *= 1.f / (1.f + __expf(-o2)); y[3] *= 1.f / (1.f + __expf(-o3));
                    u32x2 w; w.x = cvt_pk_bf16(y[0], y[1]); w.y = cvt_pk_bf16(y[2], y[3]);
                    *((u32x2*)(HM + (size_t)row * D + hh * 256) + lane) = w;
#if DBG_NO_ATTN
                    *((u32x2*)(HM + (size_t)row * D + 1024 + hh * 256) + lane) = (u32x2){0u, 0u};
#endif
                }
            }
            }
    GRID_SYNC();
    for (int rep_ = 0; rep_ < ((9 == DBG_REP_PH) ? 2 : 1); ++rep_) { constexpr int ph = 9; PH_THREAD(); if (rep_) { asm volatile("s_waitcnt vmcnt(0)" ::: "memory"); __syncthreads(); }
            const int s = (ph == 3) ? 0 : (ph == 9 ? 1 : 2);
            const bf16_t* A = (ph == 9) ? HM : Hb; const bf16_t* Wt = (const bf16_t*)(ws + (ph == 3 ? WS_W2A : (ph == 9 ? WS_WOUT : WS_W2B)));
            const int K = (ph == 9) ? D : FF;
            const float* Xr = (ph == 3) ? x_in : X;
            pg8::Gemm g{A, Wt, K, K, K}; pg8::StaticOrder S; S.init(M, D, G, bid);
            pg8::EpiResid E{Xr, Z, MOD + s * 6144 + 4096, (ph == 9) ? 1.0f : 0.5f};
            pg8::gemm_phase<pg8::EpiResid, pg8::StaticOrder, true>(lds, g, S, E);
            }
    GRID_SYNC();
    for (int rep_ = 0; rep_ < ((10 == DBG_REP_PH) ? 2 : 1); ++rep_) { constexpr int ph = 10; PH_THREAD(); if (rep_) { asm volatile("s_waitcnt vmcnt(0)" ::: "memory"); __syncthreads(); }
            const int s = (ph == 4) ? 1 : 2;
            const float* gp = args.in[ph == 4 ? 7 : (ph == 10 ? 20 : 25)]; const float* bp = args.in[ph == 4 ? 8 : (ph == 10 ? 21 : 26)];
            float* Xo = (ph == 13) ? args.out : X;
            for (int row = gw; row < M; row += NGW) {
                const int b = row >> 11; const float* mb = MOD + (size_t)b * NMOD + s * 6144;
                const f32x4* zr = (const f32x4*)(Z + (size_t)row * D) + lane;
                f32x4 v[8]; float sm = 0.f;
#pragma unroll
                for (int j = 0; j < 8; ++j) { v[j] = zr[64 * j]; sm += (v[j][0] + v[j][1]) + (v[j][2] + v[j][3]); }
                const float mean = wave_sum(sm) * (1.f / D); float s2 = 0.f;
#pragma unroll
                for (int j = 0; j < 8; ++j) { v[j] = v[j] - mean; s2 += (v[j][0] * v[j][0] + v[j][1] * v[j][1]) + (v[j][2] * v[j][2] + v[j][3] * v[j][3]); }
                const float rstd = 1.f / sqrtf(wave_sum(s2) * (1.f / D) + LN_EPS);
                f32x4* xo = (f32x4*)(Xo + (size_t)row * D) + lane; u32x2* ur = (u32x2*)(U + (size_t)row * D) + lane;
#pragma unroll
                for (int j = 0; j < 8; ++j) {
                    const f32x4 gg = *((const f32x4*)gp + lane + 64 * j), bb = *((const f32x4*)bp + lane + 64 * j);
                    const f32x4 y = v[j] * rstd * gg + bb; xo[64 * j] = y;
                    if (ph != 13) { const f32x4 sh = *((const f32x4*)mb + lane + 64 * j), scl = *((const f32x4*)(mb + 2048) + lane + 64 * j);
                        const f32x4 uu = y * (scl + 1.0f) + sh; u32x2 w; w.x = cvt_pk_bf16(uu[0], uu[1]); w.y = cvt_pk_bf16(uu[2], uu[3]); ur[64 * j] = w; }
                }
            }
            }
    GRID_SYNC();
    for (int rep_ = 0; rep_ < ((11 == DBG_REP_PH) ? 2 : 1); ++rep_) { constexpr int ph = 11; PH_THREAD(); if (rep_) { asm volatile("s_waitcnt vmcnt(0)" ::: "memory"); __syncthreads(); }
            const bf16_t* Wt = (const bf16_t*)(ws + (ph == 2 ? WS_W13A : WS_W13B));
            pg8::Gemm g{U, Wt, D, D, D}; pg8::StaticOrder S; S.init(M, 2 * FF, G, bid);
            pg8::EpiSwiglu E{Hb};
            pg8::gemm_phase<pg8::EpiSwiglu, pg8::StaticOrder, true>(lds, g, S, E);
            }
    GRID_SYNC();
    for (int rep_ = 0; rep_ < ((12 == DBG_REP_PH) ? 2 : 1); ++rep_) { constexpr int ph = 12; PH_THREAD(); if (rep_) { asm volatile("s_waitcnt vmcnt(0)" ::: "memory"); __syncthreads(); }
            const int s = (ph == 3) ? 0 : (ph == 9 ? 1 : 2);
            const bf16_t* A = (ph == 9) ? HM : Hb; const bf16_t* Wt = (const bf16_t*)(ws + (ph == 3 ? WS_W2A : (ph == 9 ? WS_WOUT : WS_W2B)));
            const int K = (ph == 9) ? D : FF;
            const float* Xr = (ph == 3) ? x_in : X;
            pg8::Gemm g{A, Wt, K, K, K}; pg8::StaticOrder S; S.init(M, D, G, bid);
            pg8::EpiResid E{Xr, Z, MOD + s * 6144 + 4096, (ph == 9) ? 1.0f : 0.5f};
            pg8::gemm_phase<pg8::EpiResid, pg8::StaticOrder, true>(lds, g, S, E);
            }
    GRID_SYNC();
    for (int rep_ = 0; rep_ < ((13 == DBG_REP_PH) ? 2 : 1); ++rep_) { constexpr int ph = 13; PH_THREAD(); if (rep_) { asm volatile("s_waitcnt vmcnt(0)" ::: "memory"); __syncthreads(); }
            const int s = (ph == 4) ? 1 : 2;
            const float* gp = args.in[ph == 4 ? 7 : (ph == 10 ? 20 : 25)]; const float* bp = args.in[ph == 4 ? 8 : (ph == 10 ? 21 : 26)];
            float* Xo = (ph == 13) ? args.out : X;
            for (int row = gw; row < M; row += NGW) {
                const int b = row >> 11; const float* mb = MOD + (size_t)b * NMOD + s * 6144;
                const f32x4* zr = (const f32x4*)(Z + (size_t)row * D) + lane;
                f32x4 v[8]; float sm = 0.f;
#pragma unroll
                for (int j = 0; j < 8; ++j) { v[j] = zr[64 * j]; sm += (v[j][0] + v[j][1]) + (v[j][2] + v[j][3]); }
                const float mean = wave_sum(sm) * (1.f / D); float s2 = 0.f;
#pragma unroll
                for (int j = 0; j < 8; ++j) { v[j] = v[j] - mean; s2 += (v[j][0] * v[j][0] + v[j][1] * v[j][1]) + (v[j][2] * v[j][2] + v[j][3] * v[j][3]); }
                const float rstd = 1.f / sqrtf(wave_sum(s2) * (1.f / D) + LN_EPS);
                f32x4* xo = (f32x4*)(Xo + (size_t)row * D) + lane; u32x2* ur = (u32x2*)(U + (size_t)row * D) + lane;
#pragma unroll
                for (int j = 0; j < 8; ++j) {
                    const f32x4 gg = *((const f32x4*)gp + lane + 64 * j), bb = *((const f32x4*)bp + lane + 64 * j);
                    const f32x4 y = v[j] * rstd * gg + bb; xo[64 * j] = y;
                    if (ph != 13) { const f32x4 sh = *((const f32x4*)mb + lane + 64 * j), scl = *((const f32x4*)(mb + 2048) + lane + 64 * j);
                        const f32x4 uu = y * (scl + 1.0f) + sh; u32x2 w; w.x = cvt_pk_bf16(uu[0], uu[1]); w.y = cvt_pk_bf16(uu[2], uu[3]); ur[64 * j] = w; }
                }
            }
            }
}

extern "C" void kernel_launch(void* const* d_in, const int* in_sizes, int n_in, void* d_out, int out_size, void* d_ws, size_t ws_size, hipStream_t stream) {
    static int grid = 0;
    if (grid == 0) {
        if (n_in != 27 || out_size != M * D || ws_size < WS_END) { fprintf(stderr, "kernel_launch: unexpected shapes (n_in %d out %d ws %zu need %zu)\n", n_in, out_size, ws_size, (size_t)WS_END); grid = -1; return; }
        int dev = 0, cus = 0, per_cu = 0;
        hipGetDevice(&dev); hipDeviceGetAttribute(&cus, hipDeviceAttributeMultiprocessorCount, dev);
        if (hipFuncSetAttribute((const void*)fwd_kernel, hipFuncAttributeMaxDynamicSharedMemorySize, LDS_BYTES) != hipSuccess) { fprintf(stderr, "kernel_launch: hipFuncSetAttribute failed\n"); grid = -1; return; }
        hipOccupancyMaxActiveBlocksPerMultiprocessor(&per_cu, (const void*)fwd_kernel, 512, LDS_BYTES);
        (void)hipGetLastError();
        if (per_cu < 1) { fprintf(stderr, "kernel_launch: occupancy query says %d blocks/CU\n", per_cu); per_cu = 1; }
        grid = cus;
    }
    if (grid < 0) return;
    if (hipMemsetAsync(d_ws, 0, 16384, stream) != hipSuccess) { fprintf(stderr, "kernel_launch: memset of barrier words failed\n"); return; }
    Args a{};
    for (int i = 0; i < 27; ++i) a.in[i] = (const float*)d_in[i];
    a.out = (float*)d_out; a.ws = (unsigned char*)d_ws;
    void* kargs[] = {&a};
    hipError_t e = hipLaunchCooperativeKernel((const void*)fwd_kernel, dim3(grid), dim3(512), kargs, LDS_BYTES, stream);
    if (e != hipSuccess) fprintf(stderr, "kernel_launch: cooperative launch failed: %s (grid %d)\n", hipGetErrorString(e), grid);
}
```

```cpp
#include <hip/hip_runtime.h>
#include <hip/hip_cooperative_groups.h>
#include <cstdio>
#include <cstdint>
namespace cg = cooperative_groups;

#define LAS __attribute__((address_space(3)))
typedef unsigned short bf16_t;
typedef short bf16x8 __attribute__((ext_vector_type(8)));
typedef short bf16x4 __attribute__((ext_vector_type(4)));
typedef float f32x4 __attribute__((ext_vector_type(4)));
typedef float f32x2 __attribute__((ext_vector_type(2)));
typedef float f32x16 __attribute__((ext_vector_type(16)));
typedef unsigned u32x4 __attribute__((ext_vector_type(4)));
typedef unsigned u32x2 __attribute__((ext_vector_type(2)));

#ifndef DBG_NO_MLSTM
#define DBG_NO_MLSTM 0
#endif
#ifndef DBG_WHICH
#define DBG_WHICH 7
#endif
#ifndef DBG_SELFTEST
#define DBG_SELFTEST 0
#endif
#ifndef DBG_XSYNC
#define DBG_XSYNC 0
#endif
#ifndef DBG_MIX2
#define DBG_MIX2 0
#endif
#ifndef DBG_REP_SUB
#define DBG_REP_SUB 0
#endif
#ifndef DBG_REP_PH
#define DBG_REP_PH -1
#endif
#ifndef DBG_NO_ATTN
#define DBG_NO_ATTN 0
#endif

constexpr int SEQ = 2048, NB = 4, M = NB * SEQ, D = 2048, FF = 5632, NIN = 4096, DIN = 3912, NMOD = 18432;
constexpr float ALPHA = 1.189207115002721f;
constexpr float LN_EPS = 1e-5f;
constexpr float QSCALE = 0.07216878364870322f * 1.4426950408889634f;
constexpr int COL_CQ = 3080, COL_CKV = 3592, COL_KR = 3848;

constexpr size_t MiB = 1u << 20;
constexpr size_t WS_MOD = 1 * MiB, WS_ROPE = 2 * MiB, WS_GATES = 3 * MiB;
constexpr size_t WS_W13A = 4 * MiB, WS_W2A = 48 * MiB, WS_W13B = 70 * MiB, WS_W2B = 114 * MiB;
constexpr size_t WS_WIN = 136 * MiB, WS_WUQ = 152 * MiB, WS_WK = 154 * MiB, WS_WV = WS_WK + 524288, WS_WOUT = 156 * MiB;
constexpr size_t WS_U = 164 * MiB, WS_Z = 196 * MiB, WS_X = 260 * MiB, WS_R = 324 * MiB;
constexpr size_t WS_H = WS_R;
constexpr size_t WS_P = WS_R, WS_QA = WS_R + 64 * MiB, WS_KN = WS_R + 88 * MiB, WS_VT = WS_R + 104 * MiB, WS_HM = WS_R + 120 * MiB, WS_HRAW = WS_R + 152 * MiB;
constexpr size_t WS_QC = WS_R + 184 * MiB, WS_KC = WS_R + 192 * MiB, WS_VTM = WS_R + 200 * MiB, WS_EG = WS_R + 216 * MiB, WS_MG = WS_EG + 131072;
constexpr size_t WS_END = WS_R + 217 * MiB;

constexpr int LDS_BYTES = 147456;
constexpr int TAB_OFF = 131072 + 1024;

__device__ __forceinline__ unsigned cvt_pk_bf16(float lo, float hi) { unsigned r; asm volatile("v_cvt_pk_bf16_f32 %0, %1, %2" : "=v"(r) : "v"(lo), "v"(hi)); return r; }
__device__ __forceinline__ float bf2f(unsigned short b) { return __builtin_bit_cast(float, (unsigned)b << 16); }
__device__ __forceinline__ float bflo(unsigned w) { return __builtin_bit_cast(float, w << 16); }
__device__ __forceinline__ float bfhi(unsigned w) { return __builtin_bit_cast(float, w & 0xffff0000u); }
__device__ __forceinline__ float wave_sum(float v) {
#pragma unroll
    for (int o = 1; o < 64; o <<= 1) v += __shfl_xor(v, o);
    return v;
}
__device__ __forceinline__ float silu_f(float a) { return a * __builtin_amdgcn_rcpf(1.f + __expf(-a)); }
#define LDS_WAIT() asm volatile("s_waitcnt lgkmcnt(0)" ::: "memory")
__device__ __forceinline__ int opaque_int(int v) { asm volatile("" : "+s"(v)); return v; }
__device__ __forceinline__ int opaque_tid() { int t = threadIdx.x; asm volatile("" : "+v"(t)); return t; }


#define XB_TMO      128
#define XB_XCNT(j)  (256  + 64 * (j))
#define XB_XSUB(j)  (1280 + 64 * (j))
#define XB_XGEN(j)  (2304 + 64 * (j))
#define XB_TOP      3328
#define XB_TOPGEN   3392
#define XCD_BAR_WORDS 3456
#define XB_SPIN_CAP (1u << 18)
__device__ __forceinline__ unsigned xb_ld(unsigned* p)              { return __hip_atomic_load(p, __ATOMIC_RELAXED, __HIP_MEMORY_SCOPE_AGENT); }
__device__ __forceinline__ unsigned xb_add(unsigned* p, unsigned v) { return __hip_atomic_fetch_add(p, v, __ATOMIC_RELAXED, __HIP_MEMORY_SCOPE_AGENT); }
__device__ __forceinline__ unsigned xb_xcc_id() { return (unsigned)__builtin_amdgcn_s_getreg((3 << 11) | 20) & 0xFu; }
#define XB_SPIN(cond, bar) do { unsigned _sp = 0; while (cond) { __builtin_amdgcn_s_sleep(1); \
    if ((++_sp & 255u) == 0u) { if (xb_ld(&(bar)[XB_TMO])) break; if (_sp > XB_SPIN_CAP) { atomicAdd(&(bar)[XB_TMO], 1u); break; } } } } while (0)
struct XcdBarrier { unsigned* bar; unsigned x; volatile LAS unsigned* st; };
__device__ __forceinline__ XcdBarrier xcd_barrier_post(unsigned* bar, volatile LAS unsigned* st) {
    XcdBarrier b; b.bar = bar; b.x = xb_xcc_id(); b.st = st;
    if (threadIdx.x == 0) (void)xb_add(&bar[XB_XCNT(b.x)], 1u);
    return b;
}
__device__ __forceinline__ void xcd_barrier_complete(unsigned* bar, unsigned x, unsigned& nloc, unsigned& nx) {
    const unsigned G = gridDim.x * gridDim.y * gridDim.z;
    unsigned sum, cnt, mine, sp = 0u;
    for (;;) {
        sum = 0u; cnt = 0u; mine = 0u;
#pragma unroll
        for (unsigned j = 0; j < 16; ++j) { const unsigned c = xb_ld(&bar[XB_XCNT(j)]); sum += c; cnt += (c > 0u) ? 1u : 0u; mine = (j == x) ? c : mine; }
        if (sum == G) break;
        __builtin_amdgcn_s_sleep(1);
        if ((++sp & 255u) == 0u) { if (xb_ld(&bar[XB_TMO])) break; if (sp > XB_SPIN_CAP) { atomicAdd(&bar[XB_TMO], 1u); break; } }
    }
    nloc = mine > 0u ? mine : 1u; nx = cnt > 0u ? cnt : 1u;
}
__device__ __forceinline__ void xcd_barrier(const XcdBarrier& b) {
    asm volatile("s_waitcnt vmcnt(0)" ::: "memory");
    __syncthreads();
    if (threadIdx.x == 0) {
        unsigned* bar = b.bar;
        __builtin_amdgcn_s_waitcnt(0);
        unsigned nloc = b.st[0], nx = b.st[1];
        if (nloc == 0u) { xcd_barrier_complete(bar, b.x, nloc, nx); b.st[0] = nloc; b.st[1] = nx; }
        const unsigned old = xb_add(&bar[XB_XSUB(b.x)], 1u);
        const unsigned gen = old / nloc;
        if (old + 1u == (gen + 1u) * nloc) {
            __builtin_amdgcn_fence(__ATOMIC_RELEASE, "agent");
            asm volatile("s_waitcnt vmcnt(0)" ::: "memory");
            const unsigned og = xb_add(&bar[XB_TOP], 1u);
            const unsigned tg = og / nx;
            if (og + 1u == (tg + 1u) * nx) xb_add(&bar[XB_TOPGEN], 1u);
            else XB_SPIN(xb_ld(&bar[XB_TOPGEN]) == tg, bar);
            __builtin_amdgcn_fence(__ATOMIC_ACQUIRE, "agent");
            xb_add(&bar[XB_XGEN(b.x)], 1u);
            asm volatile("s_waitcnt vmcnt(0)" ::: "memory");
        } else {
            XB_SPIN(xb_ld(&bar[XB_XGEN(b.x)]) == gen, bar);
            __builtin_amdgcn_fence(__ATOMIC_ACQUIRE, "agent");
            asm volatile("s_waitcnt vmcnt(0)" ::: "memory");
        }
    }
    __syncthreads();
}

namespace pg8 {
constexpr int BM = 256, BK = 64, HALF = 128, HTB = HALF * BK * 2, STAGE_BYTES = 8 * HTB, NXCD = 8, WGM = 8;
__host__ __device__ __forceinline__ int lds_byte(int r, int c) { const int st = (r >> 4) * 2 + (c >> 5), rr = r & 15, cc = c & 31, ob = rr * 64 + cc * 2; return st * 1024 + (ob ^ (((ob >> 9) & 1) << 5)); }
__host__ __device__ __forceinline__ void stage_rc(int b, int& R, int& C) { const int st = b / 1024, sb = b % 1024, swz = sb ^ (((sb >> 9) & 1) << 5); R = (st >> 1) * 16 + swz / 64; C = (st & 1) * 32 + (swz % 64) / 2; }
__host__ __device__ __forceinline__ int perm32(int rho) { const int n = rho >> 4, i = rho & 15; return 8 * (i >> 2) + 4 * n + (i & 3); }

struct Unit { int pm, pn; };
struct Gemm { const bf16_t* A; const bf16_t* Bt; int lda, ldb, K; };

struct StaticOrder {
    int nM, nN, nwg, G, c;
    __device__ void init(int Mr, int Nc, int G_, int c_) { nM = Mr / BM; nN = Nc / BM; nwg = nM * nN; G = G_; c = c_; }
    __device__ bool next(int i, Unit& u) const {
        const long L = (long)i * G + c; if (L >= nwg) return false;
        int wgid = (int)L; { const int q = nwg / NXCD, r = nwg % NXCD, xcd = wgid % NXCD, off = wgid / NXCD; wgid = (xcd < r ? xcd * (q + 1) : r * (q + 1) + (xcd - r) * q) + off; }
        const int nig = WGM * nN, gid = wgid / nig, fm = gid * WGM, gsz = (nM - fm) < WGM ? (nM - fm) : WGM;
        u.pm = fm + ((wgid % nig) % gsz); u.pn = (wgid % nig) / gsz; return true;
    }
};
struct SingleUnit { Unit u0; __device__ bool next(int i, Unit& u) const { if (i != 0) return false; u = u0; return true; } };

template <class Epi, class Sched, bool ALIGN_EPI>
__device__ __forceinline__ void gemm_phase(LAS unsigned char* lds, const Gemm g, const Sched& S, const Epi& E) {
    const int tid = opaque_tid(), wid = __builtin_amdgcn_readfirstlane(tid >> 6), lane = tid & 63, wr = wid >> 2, wc = wid & 3, fr = lane & 15, fq = lane >> 4;
    const int K = g.K, nt = K / BK;
    unsigned voffA[2], voffB[2];
#pragma unroll
    for (int i = 0; i < 2; ++i) { int R, C; stage_rc(tid * 16 + i * 8192, R, C); const int Rb = Epi::PERM ? ((R & ~31) + perm32(R & 31)) : R;
        voffA[i] = (unsigned)(R * g.lda + C) * 2u; voffB[i] = (unsigned)(Rb * g.ldb + C) * 2u; }
    const size_t kstep = (size_t)(BK * 2);
    const size_t hstepA = (size_t)HALF * g.lda * 2, hstepB = (size_t)HALF * g.ldb * 2;
    const size_t tstepA = 2 * hstepA, tstepB = 2 * hstepB;
    const unsigned ldsw = (unsigned)wid * 1024u;
    const int aoff = lds_byte(wr * 64 + fr, fq * 8), boff = lds_byte(wc * 32 + fr, fq * 8);
#define PG8_SA(b, h) (((b) * 2 + (h)) * HTB)
#define PG8_SB(b, h) ((4 + (b) * 2 + (h)) * HTB)
#define PG8_STAGE(bufoff, gbase, voff) do { _Pragma("unroll") for (int _i = 0; _i < 2; ++_i) \
        __builtin_amdgcn_global_load_lds((const unsigned*)((const char*)(gbase) + (voff)[_i]), (LAS unsigned*)(lds + (bufoff) + ldsw + _i * 8192), 16, 0, 0); } while (0)
#define PG8_LDA(dst, b, h) do { _Pragma("unroll") for (int m = 0; m < 4; ++m) _Pragma("unroll") for (int k = 0; k < 2; ++k) dst[m][k] = *(const LAS bf16x8*)(lds + PG8_SA(b, h) + aoff + m * 2048 + k * 1024); } while (0)
#define PG8_LDB(dst, b, h) do { _Pragma("unroll") for (int n = 0; n < 2; ++n) _Pragma("unroll") for (int k = 0; k < 2; ++k) dst[n][k] = *(const LAS bf16x8*)(lds + PG8_SB(b, h) + boff + n * 2048 + k * 1024); } while (0)
#define PG8_MMA(ai, bj, At, Bt) do { __builtin_amdgcn_s_setprio(1); _Pragma("unroll") for (int m = 0; m < 4; ++m) _Pragma("unroll") for (int n = 0; n < 2; ++n) _Pragma("unroll") for (int k = 0; k < 2; ++k) \
        acc[ai][bj][m][n] = __builtin_amdgcn_mfma_f32_16x16x32_bf16(Bt[n][k], At[m][k], acc[ai][bj][m][n], 0, 0, 0); __builtin_amdgcn_s_setprio(0); } while (0)
#define PG8_WAIT_V(n) asm volatile("s_waitcnt vmcnt(" #n ")" ::: "memory")
#define PG8_WAIT_L(n) asm volatile("s_waitcnt lgkmcnt(" #n ")" ::: "memory")
#define PG8_BAR __builtin_amdgcn_s_barrier()
#define PG8_SCHED __builtin_amdgcn_sched_barrier(0)
    Unit cur, nxt; int ui = 0;
    if (!S.next(0, cur)) return;
    f32x4 acc[2][2][4][2];
#pragma unroll
    for (int a = 0; a < 2; ++a)
#pragma unroll
        for (int b = 0; b < 2; ++b)
#pragma unroll
            for (int m = 0; m < 4; ++m)
#pragma unroll
                for (int n = 0; n < 2; ++n) acc[a][b][m][n] = (f32x4){0.f, 0.f, 0.f, 0.f};
    bf16x8 At[4][2], B0[2][2], B1[2][2];
    const char* cA = (const char*)g.A + (size_t)cur.pm * tstepA; const char* cB = (const char*)g.Bt + (size_t)cur.pn * tstepB;
    PG8_STAGE(PG8_SB(0, 0), cB, voffB); PG8_STAGE(PG8_SB(0, 1), cB + hstepB, voffB); PG8_STAGE(PG8_SA(0, 0), cA, voffA); PG8_STAGE(PG8_SA(0, 1), cA + hstepA, voffA);
    if (wr == 1) PG8_BAR;
    PG8_WAIT_V(2); PG8_BAR;
    PG8_STAGE(PG8_SB(1, 0), cB + kstep, voffB); PG8_STAGE(PG8_SA(1, 0), cA + kstep, voffA); PG8_STAGE(PG8_SB(1, 1), cB + hstepB + kstep, voffB);
    PG8_WAIT_V(6); PG8_BAR;
    for (;;) {
        const bool has_next = S.next(ui + 1, nxt);
        const char* nA = has_next ? (const char*)g.A + (size_t)nxt.pm * tstepA : cA; const char* nB = has_next ? (const char*)g.Bt + (size_t)nxt.pn * tstepB : cB;
        for (int t = 0; t < nt; t += 2) {
            const bool last = (t == nt - 2);
            const char* a1 = cA + (size_t)(t + 1) * kstep;
            const char* a2 = last ? nA : cA + (size_t)(t + 2) * kstep; const char* b2 = last ? nB : cB + (size_t)(t + 2) * kstep;
            const char* a3 = a2 + kstep; const char* b3 = b2 + kstep;
            PG8_LDB(B0, 0, 0); PG8_LDB(B1, 0, 1); PG8_SCHED; PG8_LDA(At, 0, 0); PG8_STAGE(PG8_SA(1, 1), a1 + hstepA, voffA);
            PG8_WAIT_V(8); PG8_WAIT_L(0); PG8_BAR; PG8_MMA(0, 0, At, B0); PG8_MMA(0, 1, At, B1); PG8_BAR; PG8_SCHED;
            PG8_LDA(At, 0, 1); PG8_STAGE(PG8_SB(0, 0), b2, voffB); PG8_STAGE(PG8_SB(0, 1), b2 + hstepB, voffB); PG8_STAGE(PG8_SA(0, 0), a2, voffA);
            PG8_WAIT_V(8); PG8_WAIT_L(0); PG8_BAR; PG8_MMA(1, 0, At, B0); PG8_MMA(1, 1, At, B1); PG8_BAR; PG8_SCHED;
            PG8_LDB(B0, 1, 0); PG8_LDB(B1, 1, 1); PG8_SCHED; PG8_LDA(At, 1, 0); PG8_STAGE(PG8_SA(0, 1), a2 + hstepA, voffA);
            PG8_WAIT_V(8); PG8_WAIT_L(0); PG8_BAR; PG8_MMA(0, 0, At, B0); PG8_MMA(0, 1, At, B1); PG8_BAR; PG8_SCHED;
            PG8_LDA(At, 1, 1); PG8_STAGE(PG8_SB(1, 0), b3, voffB); PG8_STAGE(PG8_SB(1, 1), b3 + hstepB, voffB); PG8_STAGE(PG8_SA(1, 0), a3, voffA);
            PG8_WAIT_V(8); PG8_WAIT_L(0); PG8_BAR; PG8_MMA(1, 0, At, B0); PG8_MMA(1, 1, At, B1); PG8_BAR; PG8_SCHED;
        }
        if constexpr (ALIGN_EPI) { if (wr == 0) PG8_BAR; }
        E(acc, cur, wr, wc, fr, fq);
        if (!has_next) break;
#pragma unroll
        for (int a = 0; a < 2; ++a)
#pragma unroll
            for (int b = 0; b < 2; ++b)
#pragma unroll
                for (int m = 0; m < 4; ++m)
#pragma unroll
                    for (int n = 0; n < 2; ++n) acc[a][b][m][n] = (f32x4){0.f, 0.f, 0.f, 0.f};
        cur = nxt; cA = nA; cB = nB; ++ui;
        if constexpr (ALIGN_EPI) { if (wr == 1) PG8_BAR; }
    }
    PG8_WAIT_V(0);
    if constexpr (!ALIGN_EPI) { if (wr == 0) PG8_BAR; }
    PG8_BAR;
#undef PG8_SA
#undef PG8_SB
#undef PG8_STAGE
#undef PG8_LDA
#undef PG8_LDB
#undef PG8_MMA
#undef PG8_WAIT_V
#undef PG8_WAIT_L
#undef PG8_BAR
#undef PG8_SCHED
}

typedef f32x4 Acc[2][2][4][2];

struct EpiSwiglu {
    static constexpr bool PERM = true;
    bf16_t* H;
    __device__ __forceinline__ void operator()(const Acc& acc, const Unit& u, int wr, int wc, int fr, int fq) const {
        const int row0 = u.pm * BM + wr * 64 + fr, col0 = u.pn * 128 + wc * 32 + 8 * fq;
#pragma unroll
        for (int ai = 0; ai < 2; ++ai)
#pragma unroll
            for (int m = 0; m < 4; ++m) {
                const f32x4 a0 = acc[ai][0][m][0], a1 = acc[ai][0][m][1], b0 = acc[ai][1][m][0], b1 = acc[ai][1][m][1];
                u32x4 w;
                w.x = cvt_pk_bf16(silu_f(a0[0]) * b0[0], silu_f(a0[1]) * b0[1]); w.y = cvt_pk_bf16(silu_f(a0[2]) * b0[2], silu_f(a0[3]) * b0[3]);
                w.z = cvt_pk_bf16(silu_f(a1[0]) * b1[0], silu_f(a1[1]) * b1[1]); w.w = cvt_pk_bf16(silu_f(a1[2]) * b1[2], silu_f(a1[3]) * b1[3]);
                *(u32x4*)(H + (size_t)(row0 + ai * HALF + m * 16) * FF + col0) = w;
            }
    }
};
struct EpiResid {
    static constexpr bool PERM = false;
    const float* X; float* Z; const float* gate; float coef;
    __device__ __forceinline__ void operator()(const Acc& acc, const Unit& u, int wr, int wc, int fr, int fq) const {
        const int row0 = u.pm * BM + wr * 64 + fr, b = u.pm >> 3, colb = u.pn * BM + wc * 32 + 4 * fq;
#pragma unroll
        for (int bj = 0; bj < 2; ++bj)
#pragma unroll
            for (int n = 0; n < 2; ++n) {
                const int col = colb + bj * HALF + n * 16;
                f32x4 gv = *(const f32x4*)(gate + (size_t)b * NMOD + col); gv = (gv + 1.0f) * coef;
#pragma unroll
                for (int ai = 0; ai < 2; ++ai)
#pragma unroll
                    for (int m = 0; m < 4; ++m) {
                        const size_t off = (size_t)(row0 + ai * HALF + m * 16) * D + col;
                        const f32x4 x = *(const f32x4*)(X + off);
                        *(f32x4*)(Z + off) = x * ALPHA + gv * acc[ai][bj][m][n];
                    }
            }
    }
};
__device__ __forceinline__ void rope8(f32x4& v0, f32x4& v1, const f32x2* cs) {
    const f32x2 c0 = cs[0], c1 = cs[1], c2 = cs[2], c3 = cs[3];
    float a, b;
    a = v0[0]; b = v0[1]; v0[0] = a * c0.x - b * c0.y; v0[1] = a * c0.y + b * c0.x;
    a = v0[2]; b = v0[3]; v0[2] = a * c1.x - b * c1.y; v0[3] = a * c1.y + b * c1.x;
    a = v1[0]; b = v1[1]; v1[0] = a * c2.x - b * c2.y; v1[1] = a * c2.y + b * c2.x;
    a = v1[2]; b = v1[3]; v1[2] = a * c3.x - b * c3.y; v1[3] = a * c3.y + b * c3.x;
}
struct EpiWin {
    static constexpr bool PERM = true;
    bf16_t* P; float* GATES; const f32x2* ROPE;
    __device__ __forceinline__ void operator()(const Acc& acc, const Unit& u, int wr, int wc, int fr, int fq) const {
        const int row0 = u.pm * BM + wr * 64 + fr, colb = u.pn * BM + wc * 32 + 8 * fq;
#pragma unroll
        for (int bj = 0; bj < 2; ++bj) {
            const int col = colb + bj * HALF;
            const bool isg = (col == 3072), isr = (col >= COL_KR && col < COL_KR + 64);
#pragma unroll
            for (int ai = 0; ai < 2; ++ai)
#pragma unroll
                for (int m = 0; m < 4; ++m) {
                    const int row = row0 + ai * HALF + m * 16;
                    f32x4 v0 = acc[ai][bj][m][0], v1 = acc[ai][bj][m][1];
                    if (isg) { *(f32x4*)(GATES + (size_t)row * 8) = v0; *(f32x4*)(GATES + (size_t)row * 8 + 4) = v1; }
                    if (isr) rope8(v0, v1, ROPE + (size_t)(row & (SEQ - 1)) * 32 + ((col - COL_KR) >> 1));
                    u32x4 w; w.x = cvt_pk_bf16(v0[0], v0[1]); w.y = cvt_pk_bf16(v0[2], v0[3]); w.z = cvt_pk_bf16(v1[0], v1[1]); w.w = cvt_pk_bf16(v1[2], v1[3]);
                    *(u32x4*)(P + (size_t)row * NIN + col) = w;
                }
        }
    }
};
struct EpiLR {
    static constexpr bool PERM = true;
    int mode; bf16_t* O; int ldo; const LAS float* tab; const f32x2* ROPE;
    __device__ __forceinline__ void operator()(const Acc& acc, const Unit& u, int wr, int wc, int fr, int fq) const {
#pragma unroll
        for (int bj = 0; bj < 2; ++bj) {
            const int lcol = wc * 32 + 8 * fq + bj * HALF, col = u.pn * BM + lcol;
            f32x4 c0 = {1.f, 1.f, 1.f, 1.f}, c1 = c0;
            if (mode == 2) { c0 = *(const LAS f32x4*)(tab + lcol); c1 = *(const LAS f32x4*)(tab + lcol + 4); }
            const int within = col % 192;
            const bool isr = (mode == 0) && (within >= 128);
#pragma unroll
            for (int ai = 0; ai < 2; ++ai)
#pragma unroll
                for (int m = 0; m < 4; ++m) {
                    const int lrow = wr * 64 + fr + ai * HALF + m * 16, row = u.pm * BM + lrow;
                    f32x4 v0 = acc[ai][bj][m][0] * c0, v1 = acc[ai][bj][m][1] * c1;
                    if (mode != 2) { float r = tab[lrow]; if (mode == 0) r *= QSCALE; v0 = v0 * r; v1 = v1 * r; }
                    if (isr) rope8(v0, v1, ROPE + (size_t)(row & (SEQ - 1)) * 32 + ((within - 128) >> 1));
                    u32x4 w; w.x = cvt_pk_bf16(v0[0], v0[1]); w.y = cvt_pk_bf16(v0[2], v0[3]); w.z = cvt_pk_bf16(v1[0], v1[1]); w.w = cvt_pk_bf16(v1[2], v1[3]);
                    *(u32x4*)(O + (size_t)row * ldo + col) = w;
                }
        }
    }
};
}

__device__ __forceinline__ int map_row(int kind, int n) {
    switch (kind) {
        case 0: return (n >> 7) * 256 + (n & 127);
        case 1: return (n >> 7) * 256 + 128 + (n & 127);
        case 3: { if (n < COL_KR) return n; const int j = n - COL_KR; return COL_KR + ((j < 32) ? 2 * j : 2 * (j - 32) + 1); }
        case 4: { const int h = n / 192, r = n - h * 192; if (r < 128) return n; const int j = r - 128; return h * 192 + 128 + ((j < 32) ? 2 * j : 2 * (j - 32) + 1); }
        case 5: { const int h = n >> 8, r = n & 255; return (r < 128) ? h * 128 + r : 1024 + h * 128 + (r - 128); }
        default: return n;
    }
}
constexpr int TR_LD = 68, TR_BYTES = 64 * TR_LD * 4;
__device__ __forceinline__ void tr_item(const float* W, int K, int N, bf16_t* WT, int kind, const float* gk, LAS float* scr, int item, int lane) {
    const int nblk = (N + 63) >> 6, kb = item / nblk, nb = item - kb * nblk, k0 = 64 * kb, n0 = 64 * nb;
    const int nn = n0 + 4 * (lane & 15); const bool ok = nn < N;
    f32x4 v[16];
#pragma unroll
    for (int i = 0; i < 16; ++i) { const int kk = 4 * i + (lane >> 4); v[i] = ok ? *(const f32x4*)(W + (size_t)(k0 + kk) * N + nn) : (f32x4){0.f, 0.f, 0.f, 0.f}; }
#pragma unroll
    for (int i = 0; i < 16; ++i) { const int kk = 4 * i + (lane >> 4); f32x4 x = v[i]; if (gk) x = x * gk[k0 + kk]; *(LAS f32x4*)(scr + kk * TR_LD + 4 * (lane & 15)) = x; }
    LDS_WAIT(); asm volatile("" ::: "memory");
    if (n0 + lane < N) {
        bf16_t* dst = WT + (size_t)map_row(kind, n0 + lane) * K + k0;
#pragma unroll
        for (int c = 0; c < 8; ++c) { const LAS float* sp = scr + (8 * c) * TR_LD + lane;
            u32x4 o; o.x = cvt_pk_bf16(sp[0 * TR_LD], sp[1 * TR_LD]); o.y = cvt_pk_bf16(sp[2 * TR_LD], sp[3 * TR_LD]); o.z = cvt_pk_bf16(sp[4 * TR_LD], sp[5 * TR_LD]); o.w = cvt_pk_bf16(sp[6 * TR_LD], sp[7 * TR_LD]);
            *(u32x4*)(dst + 8 * c) = o; }
    }
    LDS_WAIT(); asm volatile("" ::: "memory");
}

struct Args { const float* in[27]; float* out; unsigned char* ws; };

constexpr int AK_STRIDE = 400, AV_STRIDE = 144, AK_BUF = 64 * AK_STRIDE, AV_BUF = 128 * AV_STRIDE, AV_OFF = 2 * AK_BUF;
__device__ __forceinline__ void attn_unit(const bf16_t* QA, const bf16_t* KN, const bf16_t* P, const bf16_t* VT, bf16_t* HM, int b, int h, int qb, LAS unsigned char* lds, int tid, int wave, int lane) {
    const int tok0 = b * SEQ, q0 = qb * 256 + wave * 32, ql = lane & 31, hh = lane >> 5;
    bf16x8 qf[12];
    { const bf16_t* qp = QA + (size_t)(tok0 + q0 + ql) * 1536 + h * 192 + 8 * hh;
#pragma unroll
      for (int kb = 0; kb < 12; ++kb) qf[kb] = *(const bf16x8*)(qp + 16 * kb); }
    f32x16 o[4];
#pragma unroll
    for (int e = 0; e < 4; ++e)
#pragma unroll
        for (int r = 0; r < 16; ++r) o[e][r] = 0.f;
    float mrun = -1e30f, lrun = 0.f;
    const int ntiles = 4 * (qb + 1);
    const bf16_t* KNb = KN + (size_t)tok0 * 1024 + h * 128; const bf16_t* KRb = P + (size_t)tok0 * NIN + COL_KR; const bf16_t* VTb = VT + (size_t)(h * 128) * M + tok0;
    int ksrc[3], kdst[3], vsrc[2], vdst[2];
#pragma unroll
    for (int i = 0; i < 2; ++i) { const int c = tid + 512 * i, key = c >> 4, cc = c & 15; ksrc[i] = key * 1024 + 8 * cc; kdst[i] = key * AK_STRIDE + cc * 16; }
    { const int key = tid >> 3, cc = tid & 7; ksrc[2] = key * NIN + 8 * cc; kdst[2] = key * AK_STRIDE + (16 + cc) * 16; }
#pragma unroll
    for (int i = 0; i < 2; ++i) { const int c = tid + 512 * i, e = c >> 3, cc = c & 7; vsrc[i] = e * M + 8 * cc; vdst[i] = AV_OFF + e * AV_STRIDE + cc * 16; }
    u32x4 kr[3], vr[2];
#pragma unroll
    for (int i = 0; i < 3; ++i) kr[i] = *(const u32x4*)((i < 2 ? KNb : KRb) + ksrc[i]);
#pragma unroll
    for (int i = 0; i < 2; ++i) vr[i] = *(const u32x4*)(VTb + vsrc[i]);
#pragma unroll
    for (int i = 0; i < 3; ++i) *(LAS u32x4*)(lds + kdst[i]) = kr[i];
#pragma unroll
    for (int i = 0; i < 2; ++i) *(LAS u32x4*)(lds + vdst[i]) = vr[i];
    __syncthreads();
    for (int kt = 0; kt < ntiles; ++kt) {
        const int cur = kt & 1;
        const bool more = (kt + 1 < ntiles);
        if (more) {
#pragma unroll
            for (int i = 0; i < 3; ++i) kr[i] = *(const u32x4*)((i < 2 ? KNb + (size_t)(kt + 1) * 65536 : KRb + (size_t)(kt + 1) * (64 * NIN)) + ksrc[i]);
#pragma unroll
            for (int i = 0; i < 2; ++i) vr[i] = *(const u32x4*)(VTb + (kt + 1) * 64 + vsrc[i]);
        }
        if (kt * 64 <= q0 + 31) {
            const LAS unsigned char* kb_ = lds + cur * AK_BUF;
            const LAS unsigned char* vb_ = lds + AV_OFF + cur * AV_BUF;
            f32x16 st[2];
#pragma unroll
            for (int t = 0; t < 2; ++t) {
#pragma unroll
                for (int r = 0; r < 16; ++r) st[t][r] = 0.f;
#pragma unroll
                for (int kb = 0; kb < 12; ++kb) {
                    const bf16x8 a = *(const LAS bf16x8*)(kb_ + (32 * t + ql) * AK_STRIDE + (16 * kb + 8 * hh) * 2);
                    st[t] = __builtin_amdgcn_mfma_f32_32x32x16_bf16(a, qf[kb], st[t], 0, 0, 0);
                }
            }
            if (kt * 64 + 63 > q0) {
                const int qpos = q0 + ql;
#pragma unroll
                for (int t = 0; t < 2; ++t)
#pragma unroll
                    for (int r = 0; r < 16; ++r) { const int key = kt * 64 + 32 * t + (r & 3) + 8 * (r >> 2) + 4 * hh; if (key > qpos) st[t][r] = -1e30f; }
            }
            float mx = -1e30f;
#pragma unroll
            for (int t = 0; t < 2; ++t)
#pragma unroll
                for (int r = 0; r < 16; ++r) mx = fmaxf(mx, st[t][r]);
            mx = fmaxf(mx, __shfl_xor(mx, 32));
            const float mnew = fmaxf(mrun, mx), alpha = __builtin_amdgcn_exp2f(mrun - mnew);
            float rs = 0.f;
#pragma unroll
            for (int t = 0; t < 2; ++t)
#pragma unroll
                for (int r = 0; r < 16; ++r) { const float p = __builtin_amdgcn_exp2f(st[t][r] - mnew); st[t][r] = p; rs += p; }
            rs += __shfl_xor(rs, 32);
            lrun = lrun * alpha + rs; mrun = mnew;
#pragma unroll
            for (int e = 0; e < 4; ++e)
#pragma unroll
                for (int r = 0; r < 16; ++r) o[e][r] *= alpha;
#pragma unroll
            for (int t = 0; t < 2; ++t) {
                bf16x8 pb[2];
#pragma unroll
                for (int kb = 0; kb < 2; ++kb) {
                    u32x4 w;
                    w.x = cvt_pk_bf16(st[t][8 * kb + 0], st[t][8 * kb + 1]); w.y = cvt_pk_bf16(st[t][8 * kb + 2], st[t][8 * kb + 3]);
                    w.z = cvt_pk_bf16(st[t][8 * kb + 4], st[t][8 * kb + 5]); w.w = cvt_pk_bf16(st[t][8 * kb + 6], st[t][8 * kb + 7]);
                    pb[kb] = __builtin_bit_cast(bf16x8, w);
                }
#pragma unroll
                for (int e = 0; e < 4; ++e)
#pragma unroll
                    for (int kb = 0; kb < 2; ++kb) {
                        const LAS unsigned char* vp = vb_ + (32 * e + ql) * AV_STRIDE + (16 * (2 * t + kb) + 4 * hh) * 2;
                        const u32x2 lo = *(const LAS u32x2*)vp, hi = *(const LAS u32x2*)(vp + 16);
                        const u32x4 av = {lo.x, lo.y, hi.x, hi.y};
                        o[e] = __builtin_amdgcn_mfma_f32_32x32x16_bf16(__builtin_bit_cast(bf16x8, av), pb[kb], o[e], 0, 0, 0);
                    }
            }
        }
        if (more) {
            LAS unsigned char* kw = lds + (cur ^ 1) * AK_BUF; LAS unsigned char* vw = lds + (cur ^ 1) * AV_BUF;
#pragma unroll
            for (int i = 0; i < 3; ++i) *(LAS u32x4*)(kw + kdst[i]) = kr[i];
#pragma unroll
            for (int i = 0; i < 2; ++i) *(LAS u32x4*)(vw + vdst[i]) = vr[i];
        }
        __syncthreads();
    }
    const float inv = 1.0f / lrun;
    bf16_t* op = HM + (size_t)(tok0 + q0 + ql) * D + 1024 + h * 128 + 4 * hh;
#pragma unroll
    for (int e = 0; e < 4; ++e)
#pragma unroll
        for (int g = 0; g < 4; ++g) {
            u32x2 w; w.x = cvt_pk_bf16(o[e][4 * g + 0] * inv, o[e][4 * g + 1] * inv); w.y = cvt_pk_bf16(o[e][4 * g + 2] * inv, o[e][4 * g + 3] * inv);
            *(u32x2*)(op + 32 * e + 8 * g) = w;
        }
}

constexpr int MK_STRIDE = 272, MK_BUF = 64 * MK_STRIDE, MV_OFF = 2 * MK_BUF, ME_OFF = MV_OFF + 2 * AV_BUF;
__device__ __forceinline__ void mlp_unit(const bf16_t* QC, const bf16_t* KC, const bf16_t* VTM, const float* EG, const float* MG, float* HRAW, int b, int h, int qb, int eh, LAS unsigned char* lds, int tid, int wave, int lane) {
    const int tok0 = b * SEQ, q0 = qb * 256 + wave * 32, ql = lane & 31, hh = lane >> 5, bh = b * 4 + h;
    bf16x8 qf[8];
    { const bf16_t* qp = QC + (size_t)(tok0 + q0 + ql) * 512 + h * 128 + 8 * hh;
#pragma unroll
      for (int kb = 0; kb < 8; ++kb) qf[kb] = *(const bf16x8*)(qp + 16 * kb); }
    const float mg = MG[bh * SEQ + q0 + ql];
    f32x16 o[4];
#pragma unroll
    for (int e = 0; e < 4; ++e)
#pragma unroll
        for (int r = 0; r < 16; ++r) o[e][r] = 0.f;
    const int ntiles = 4 * (qb + 1);
    const bf16_t* KCb = KC + (size_t)tok0 * 512 + h * 128; const bf16_t* VTb = VTM + (size_t)(h * 256 + eh * 128) * M + tok0; const float* EGb = EG + bh * SEQ;
    int ksrc[2], kdst[2], vsrc[2], vdst[2];
#pragma unroll
    for (int i = 0; i < 2; ++i) { const int c = tid + 512 * i, key = c >> 4, cc = c & 15; ksrc[i] = key * 512 + 8 * cc; kdst[i] = key * MK_STRIDE + cc * 16; }
#pragma unroll
    for (int i = 0; i < 2; ++i) { const int c = tid + 512 * i, e = c >> 3, cc = c & 7; vsrc[i] = e * M + 8 * cc; vdst[i] = MV_OFF + e * AV_STRIDE + cc * 16; }
    u32x4 kr[2], vr[2]; float er = 0.f;
#pragma unroll
    for (int i = 0; i < 2; ++i) kr[i] = *(const u32x4*)(KCb + ksrc[i]);
#pragma unroll
    for (int i = 0; i < 2; ++i) vr[i] = *(const u32x4*)(VTb + vsrc[i]);
    if (tid < 64) er = EGb[tid];
#pragma unroll
    for (int i = 0; i < 2; ++i) *(LAS u32x4*)(lds + kdst[i]) = kr[i];
#pragma unroll
    for (int i = 0; i < 2; ++i) *(LAS u32x4*)(lds + vdst[i]) = vr[i];
    if (tid < 64) *(LAS float*)(lds + ME_OFF + 4 * tid) = er;
    __syncthreads();
    for (int kt = 0; kt < ntiles; ++kt) {
        const int cur = kt & 1;
        const bool more = (kt + 1 < ntiles);
        if (more) {
#pragma unroll
            for (int i = 0; i < 2; ++i) kr[i] = *(const u32x4*)(KCb + (size_t)(kt + 1) * (64 * 512) + ksrc[i]);
#pragma unroll
            for (int i = 0; i < 2; ++i) vr[i] = *(const u32x4*)(VTb + (kt + 1) * 64 + vsrc[i]);
            if (tid < 64) er = EGb[(kt + 1) * 64 + tid];
        }
        if (kt * 64 <= q0 + 31) {
            const LAS unsigned char* kb_ = lds + cur * MK_BUF;
            const LAS unsigned char* vb_ = lds + MV_OFF + cur * AV_BUF;
            const LAS unsigned char* eb_ = lds + ME_OFF + cur * 256;
            const int qpos = q0 + ql;
#pragma unroll
            for (int t = 0; t < 2; ++t) {
                f32x16 st;
#pragma unroll
                for (int r = 0; r < 16; ++r) st[r] = 0.f;
#pragma unroll
                for (int kb = 0; kb < 8; ++kb) {
                    const bf16x8 a = *(const LAS bf16x8*)(kb_ + (32 * t + ql) * MK_STRIDE + (16 * kb + 8 * hh) * 2);
                    st = __builtin_amdgcn_mfma_f32_32x32x16_bf16(a, qf[kb], st, 0, 0, 0);
                }
#pragma unroll
                for (int g = 0; g < 4; ++g) {
                    const f32x4 ev = *(const LAS f32x4*)(eb_ + 4 * (32 * t + 8 * g + 4 * hh));
#pragma unroll
                    for (int i = 0; i < 4; ++i) {
                        const int key = kt * 64 + 32 * t + 8 * g + 4 * hh + i;
                        const float w = __builtin_amdgcn_exp2f(fminf(ev[i] - mg, 0.f));
                        st[4 * g + i] = (key <= qpos) ? st[4 * g + i] * w : 0.f;
                    }
                }
                bf16x8 pb[2];
#pragma unroll
                for (int kb = 0; kb < 2; ++kb) {
                    u32x4 w;
                    w.x = cvt_pk_bf16(st[8 * kb + 0], st[8 * kb + 1]); w.y = cvt_pk_bf16(st[8 * kb + 2], st[8 * kb + 3]);
                    w.z = cvt_pk_bf16(st[8 * kb + 4], st[8 * kb + 5]); w.w = cvt_pk_bf16(st[8 * kb + 6], st[8 * kb + 7]);
                    pb[kb] = __builtin_bit_cast(bf16x8, w);
                }
#pragma unroll
                for (int e = 0; e < 4; ++e)
#pragma unroll
                    for (int kb = 0; kb < 2; ++kb) {
                        const LAS unsigned char* vp = vb_ + (32 * e + ql) * AV_STRIDE + (16 * (2 * t + kb) + 4 * hh) * 2;
                        const u32x2 lo = *(const LAS u32x2*)vp, hi = *(const LAS u32x2*)(vp + 16);
                        const u32x4 av = {lo.x, lo.y, hi.x, hi.y};
                        o[e] = __builtin_amdgcn_mfma_f32_32x32x16_bf16(__builtin_bit_cast(bf16x8, av), pb[kb], o[e], 0, 0, 0);
                    }
            }
        }
        if (more) {
            LAS unsigned char* kw = lds + (cur ^ 1) * MK_BUF; LAS unsigned char* vw = lds + (cur ^ 1) * AV_BUF;
#pragma unroll
            for (int i = 0; i < 2; ++i) *(LAS u32x4*)(kw + kdst[i]) = kr[i];
#pragma unroll
            for (int i = 0; i < 2; ++i) *(LAS u32x4*)(vw + vdst[i]) = vr[i];
            if (tid < 64) *(LAS float*)(lds + ME_OFF + (cur ^ 1) * 256 + 4 * tid) = er;
        }
        __syncthreads();
    }
    float* op = HRAW + (size_t)(tok0 + q0 + ql) * 1024 + h * 256 + eh * 128 + 4 * hh;
#pragma unroll
    for (int e = 0; e < 4; ++e)
#pragma unroll
        for (int g = 0; g < 4; ++g) {
            const f32x4 w = {o[e][4 * g + 0], o[e][4 * g + 1], o[e][4 * g + 2], o[e][4 * g + 3]};
            *(f32x4*)(op + 32 * e + 8 * g) = w;
        }
}

__global__ void __launch_bounds__(512, 2) fwd_kernel(Args args) {
    extern __shared__ __attribute__((aligned(16))) unsigned char lds_raw[];
    LAS unsigned char* lds = (LAS unsigned char*)lds_raw;
    cg::grid_group grid = cg::this_grid();
    const int G = gridDim.x, bid = blockIdx.x, NGW = G * 8;
    volatile LAS unsigned* bst = (volatile LAS unsigned*)(lds + LDS_BYTES - 16);
    if (threadIdx.x < 4) bst[threadIdx.x] = 0u;
    __syncthreads();
    const XcdBarrier xbar = xcd_barrier_post((unsigned*)args.ws, bst);
#define GRID_SYNC_CG() do { asm volatile("s_waitcnt vmcnt(0)" ::: "memory"); __syncthreads(); grid.sync(); } while (0)
#define GRID_SYNC() xcd_barrier(xbar)
#define PH_THREAD() const int tid = opaque_tid(), lane = tid & 63, wave = __builtin_amdgcn_readfirstlane(tid >> 6), gw = bid * 8 + wave; (void)lane; (void)gw; (void)tid
    unsigned char* ws = args.ws;
    const float* x_in = args.in[0];
    float* MOD = (float*)(ws + WS_MOD); f32x2* ROPE = (f32x2*)(ws + WS_ROPE); float* GATES = (float*)(ws + WS_GATES);
    bf16_t* U = (bf16_t*)(ws + WS_U); float* Z = (float*)(ws + WS_Z); float* X = (float*)(ws + WS_X);
    bf16_t* Hb = (bf16_t*)(ws + WS_H); bf16_t* P = (bf16_t*)(ws + WS_P); bf16_t* QA = (bf16_t*)(ws + WS_QA); bf16_t* KN = (bf16_t*)(ws + WS_KN);
    bf16_t* VT = (bf16_t*)(ws + WS_VT); bf16_t* HM = (bf16_t*)(ws + WS_HM); float* HRAW = (float*)(ws + WS_HRAW);
    bf16_t* QC = (bf16_t*)(ws + WS_QC); bf16_t* KC = (bf16_t*)(ws + WS_KC); bf16_t* VTM = (bf16_t*)(ws + WS_VTM); float* EG = (float*)(ws + WS_EG); float* MG = (float*)(ws + WS_MG);

    for (int rep_ = 0; rep_ < ((0 == DBG_REP_PH) ? 2 : 1); ++rep_) { constexpr int ph = 0; PH_THREAD(); if (rep_) { asm volatile("s_waitcnt vmcnt(0)" ::: "memory"); __syncthreads(); }
            for (int rs_ = 0; rs_ < ((DBG_REP_SUB == 1) ? 2 : 1); ++rs_)
            if (bid < 144) {
                LAS float* sc = (LAS float*)lds; LAS float* red = sc + 8192;
                const float* c = args.in[1]; const float* w_ada = args.in[2]; const float* b_ada = args.in[3];
                for (int i = tid; i < 8192; i += 512) { const float v = c[i]; sc[i] = v / (1.f + expf(-v)); }
                __syncthreads();
                const int col = bid * 128 + 2 * lane;
                float a[4][2];
#pragma unroll
                for (int b = 0; b < 4; ++b) { a[b][0] = 0.f; a[b][1] = 0.f; }
                const float* wp = w_ada + (size_t)(256 * wave) * NMOD + col;
#pragma unroll 16
                for (int k = 0; k < 256; ++k) {
                    const f32x2 v = *(const f32x2*)(wp + (size_t)k * NMOD);
#pragma unroll
                    for (int b = 0; b < 4; ++b) { const float s = sc[b * 2048 + 256 * wave + k]; a[b][0] += s * v.x; a[b][1] += s * v.y; }
                }
#pragma unroll
                for (int b = 0; b < 4; ++b) { red[(wave * 4 + b) * 128 + 2 * lane] = a[b][0]; red[(wave * 4 + b) * 128 + 2 * lane + 1] = a[b][1]; }
                __syncthreads();
                { const int b = tid >> 7, cc = tid & 127; float s = b_ada[bid * 128 + cc];
#pragma unroll
                  for (int w = 0; w < 8; ++w) s += red[(w * 4 + b) * 128 + cc];
                  MOD[(size_t)b * NMOD + bid * 128 + cc] = s; }
                __syncthreads();
            }
            for (int i = bid * 512 + tid; i < SEQ * 32; i += G * 512) {
                const int s = i >> 5, j = i & 31;
                const float inv = (float)pow(10000.0, -(double)j / 32.0);
                const float ang = (float)s * inv;
                const double rev = (double)ang * 0.15915494309189535; const float fr_ = (float)(rev - rint(rev));
                ROPE[i] = (f32x2){__builtin_amdgcn_cosf(fr_), __builtin_amdgcn_sinf(fr_)};
            }
            __syncthreads();
            LAS float* scr = (LAS float*)(lds + wave * TR_BYTES);
            constexpr int I_UP = 32 * 88, I_DN = 88 * 32, I_IN = 32 * 62, I_UQ = 8 * 24, I_KV = 4 * 32, I_WO = 32 * 32;
            constexpr int NIT0 = 3 * I_UP + I_DN + I_IN + I_UQ + I_KV + I_WO, NIT = NIT0 + I_UP + I_DN;
            int it0, itn, its;
            if (G == 256) { if (bid < 144) { it0 = gw; its = 1152; itn = 1152 * 6; } else { it0 = 1152 * 6 + (gw - 1152); its = 896; itn = NIT0; } }
            else { it0 = gw; its = NGW; itn = NIT; }
            for (int rs_ = 0; rs_ < ((DBG_REP_SUB == 2) ? 2 : 1); ++rs_)
            for (int it = it0; it < itn; it += its) {
                int r = it;
                if (r < I_UP) { tr_item(args.in[4], D, FF, (bf16_t*)(ws + WS_W13A), 0, nullptr, scr, r, lane); continue; } r -= I_UP;
                if (r < I_UP) { tr_item(args.in[5], D, FF, (bf16_t*)(ws + WS_W13A), 1, nullptr, scr, r, lane); continue; } r -= I_UP;
                if (r < I_DN) { tr_item(args.in[6], FF, D, (bf16_t*)(ws + WS_W2A), 2, nullptr, scr, r, lane); continue; } r -= I_DN;
                if (r < I_IN) { tr_item(args.in[9], D, DIN, (bf16_t*)(ws + WS_WIN), 3, nullptr, scr, r, lane); continue; } r -= I_IN;
                if (r < I_UQ) { tr_item(args.in[16], 512, 1536, (bf16_t*)(ws + WS_WUQ), 4, args.in[15], scr, r, lane); continue; } r -= I_UQ;
                if (r < I_KV) { tr_item(args.in[18], 256, 2048, (bf16_t*)(ws + WS_WK), 5, args.in[17], scr, r, lane); continue; } r -= I_KV;
                if (r < I_WO) { tr_item(args.in[19], D, D, (bf16_t*)(ws + WS_WOUT), 2, nullptr, scr, r, lane); continue; } r -= I_WO;
                if (r < I_UP) { tr_item(args.in[22], D, FF, (bf16_t*)(ws + WS_W13B), 0, nullptr, scr, r, lane); continue; } r -= I_UP;
                if (r < I_UP) { tr_item(args.in[23], D, FF, (bf16_t*)(ws + WS_W13B), 1, nullptr, scr, r, lane); continue; } r -= I_UP;
                tr_item(args.in[24], FF, D, (bf16_t*)(ws + WS_W2B), 2, nullptr, scr, r, lane);
            }
    }
    if (args.ws == nullptr) grid.sync();
    GRID_SYNC();
    for (int rep_ = 0; rep_ < ((1 == DBG_REP_PH) ? 2 : 1); ++rep_) { constexpr int ph = 1; PH_THREAD(); if (rep_) { asm volatile("s_waitcnt vmcnt(0)" ::: "memory"); __syncthreads(); }
            for (int row = gw; row < M; row += NGW) {
                const int b = row >> 11; const float* mb = MOD + (size_t)b * NMOD;
                const f32x4* xr = (const f32x4*)(x_in + (size_t)row * D) + lane; u32x2* ur = (u32x2*)(U + (size_t)row * D) + lane;
#pragma unroll
                for (int j = 0; j < 8; ++j) { const f32x4 v = xr[64 * j]; const f32x4 sh = *((const f32x4*)mb + lane + 64 * j), scl = *((const f32x4*)(mb + 2048) + lane + 64 * j);
                    const f32x4 y = v * (scl + 1.0f) + sh; u32x2 w; w.x = cvt_pk_bf16(y[0], y[1]); w.y = cvt_pk_bf16(y[2], y[3]); ur[64 * j] = w; }
            }
            }
    GRID_SYNC();
#if DBG_XSYNC
    for (int xs_ = 0; xs_ < DBG_XSYNC; ++xs_) GRID_SYNC();
#endif
    for (int rep_ = 0; rep_ < ((2 == DBG_REP_PH) ? 2 : 1); ++rep_) { constexpr int ph = 2; PH_THREAD(); if (rep_) { asm volatile("s_waitcnt vmcnt(0)" ::: "memory"); __syncthreads(); }
            const bf16_t* Wt = (const bf16_t*)(ws + (ph == 2 ? WS_W13A : WS_W13B));
            pg8::Gemm g{U, Wt, D, D, D}; pg8::StaticOrder S; S.init(M, 2 * FF, G, bid);
            pg8::EpiSwiglu E{Hb};
            pg8::gemm_phase<pg8::EpiSwiglu, pg8::StaticOrder, true>(lds, g, S, E);
            if (ph == 2 && G == 256 && bid >= 128) {
                constexpr int I_UP = 32 * 88, I_DN = 88 * 32;
                __syncthreads();
                LAS float* scr = (LAS float*)(lds + wave * TR_BYTES);
                for (int it = (bid - 128) * 8 + wave; it < I_UP + I_DN; it += 1024) {
                    int r = it;
                    if (r < I_UP) { tr_item(args.in[23], D, FF, (bf16_t*)(ws + WS_W13B), 1, nullptr, scr, r, lane); continue; } r -= I_UP;
                    tr_item(args.in[24], FF, D, (bf16_t*)(ws + WS_W2B), 2, nullptr, scr, r, lane);
                }
            }
            }
    GRID_SYNC();
    for (int rep_ = 0; rep_ < ((3 == DBG_REP_PH) ? 2 : 1); ++rep_) { constexpr int ph = 3; PH_THREAD(); if (rep_) { asm volatile("s_waitcnt vmcnt(0)" ::: "memory"); __syncthreads(); }
            const int s = (ph == 3) ? 0 : (ph == 9 ? 1 : 2);
            const bf16_t* A = (ph == 9) ? HM : Hb; const bf16_t* Wt = (const bf16_t*)(ws + (ph == 3 ? WS_W2A : (ph == 9 ? WS_WOUT : WS_W2B)));
            const int K = (ph == 9) ? D : FF;
            const float* Xr = (ph == 3) ? x_in : X;
            pg8::Gemm g{A, Wt, K, K, K}; pg8::StaticOrder S; S.init(M, D, G, bid);
            pg8::EpiResid E{Xr, Z, MOD + s * 6144 + 4096, (ph == 9) ? 1.0f : 0.5f};
            pg8::gemm_phase<pg8::EpiResid, pg8::StaticOrder, true>(lds, g, S, E);
            }
    GRID_SYNC();
    for (int rep_ = 0; rep_ < ((4 == DBG_REP_PH) ? 2 : 1); ++rep_) { constexpr int ph = 4; PH_THREAD(); if (rep_) { asm volatile("s_waitcnt vmcnt(0)" ::: "memory"); __syncthreads(); }
            const int s = (ph == 4) ? 1 : 2;
            const float* gp = args.in[ph == 4 ? 7 : (ph == 10 ? 20 : 25)]; const float* bp = args.in[ph == 4 ? 8 : (ph == 10 ? 21 : 26)];
            float* Xo = (ph == 13) ? args.out : X;
            for (int row = gw; row < M; row += NGW) {
                const int b = row >> 11; const float* mb = MOD + (size_t)b * NMOD + s * 6144;
                const f32x4* zr = (const f32x4*)(Z + (size_t)row * D) + lane;
                f32x4 v[8]; float sm = 0.f;
#pragma unroll
                for (int j = 0; j < 8; ++j) { v[j] = zr[64 * j]; sm += (v[j][0] + v[j][1]) + (v[j][2] + v[j][3]); }
                const float mean = wave_sum(sm) * (1.f / D); float s2 = 0.f;
#pragma unroll
                for (int j = 0; j < 8; ++j) { v[j] = v[j] - mean; s2 += (v[j][0] * v[j][0] + v[j][1] * v[j][1]) + (v[j][2] * v[j][2] + v[j][3] * v[j][3]); }
                const float rstd = 1.f / sqrtf(wave_sum(s2) * (1.f / D) + LN_EPS);
                f32x4* xo = (f32x4*)(Xo + (size_t)row * D) + lane; u32x2* ur = (u32x2*)(U + (size_t)row * D) + lane;
#pragma unroll
                for (int j = 0; j < 8; ++j) {
                    const f32x4 gg = *((const f32x4*)gp + lane + 64 * j), bb = *((const f32x4*)bp + lane + 64 * j);
                    const f32x4 y = v[j] * rstd * gg + bb; xo[64 * j] = y;
                    if (ph != 13) { const f32x4 sh = *((const f32x4*)mb + lane + 64 * j), scl = *((const f32x4*)(mb + 2048) + lane + 64 * j);
                        const f32x4 uu = y * (scl + 1.0f) + sh; u32x2 w; w.x = cvt_pk_bf16(uu[0], uu[1]); w.y = cvt_pk_bf16(uu[2], uu[3]); ur[64 * j] = w; }
                }
            }
            }
    GRID_SYNC();
    for (int rep_ = 0; rep_ < ((5 == DBG_REP_PH) ? 2 : 1); ++rep_) { constexpr int ph = 5; PH_THREAD(); if (rep_) { asm volatile("s_waitcnt vmcnt(0)" ::: "memory"); __syncthreads(); }
            pg8::Gemm g{U, (const bf16_t*)(ws + WS_WIN), D, D, D}; pg8::StaticOrder S; S.init(M, NIN, G, bid);
            pg8::EpiWin E{P, GATES, ROPE};
            pg8::gemm_phase<pg8::EpiWin, pg8::StaticOrder, true>(lds, g, S, E);
            }
    GRID_SYNC();
    for (int rep_ = 0; rep_ < ((6 == DBG_REP_PH) ? 2 : 1); ++rep_) { constexpr int ph = 6; PH_THREAD(); if (rep_) { asm volatile("s_waitcnt vmcnt(0)" ::: "memory"); __syncthreads(); }
            LAS float* tab = (LAS float*)(lds + TAB_OFF);
            for (int rs_ = 0; rs_ < ((DBG_REP_SUB == 3) ? 2 : 1); ++rs_)
            for (int L = bid; L < 448; L += G) {
                int mode, pm, pn;
                if (L < 192) { mode = 0; pm = L / 6; pn = L % 6; } else if (L < 320) { mode = 1; pm = (L - 192) >> 2; pn = (L - 192) & 3; } else { mode = 2; pm = (L - 320) & 3; pn = (L - 320) >> 2; }
                const int t0 = ((mode == 2) ? pn : pm) * 256;
                __syncthreads();
#pragma unroll
                for (int rb = 0; rb < 32; rb += 8) {
                    u32x4 wq[8];
#pragma unroll
                    for (int r = 0; r < 8; ++r) {
                        const bf16_t* pr = P + (size_t)(t0 + 32 * wave + rb + r) * NIN;
                        if (mode == 0) wq[r] = *(const u32x4*)(pr + COL_CQ + 8 * lane);
                        else { const u32x2 w2 = *(const u32x2*)(pr + COL_CKV + 4 * lane); wq[r] = (u32x4){w2.x, w2.y, 0u, 0u}; }
                    }
#pragma unroll
                    for (int r = 0; r < 8; ++r) {
                        const u32x4 w = wq[r]; const float a0 = bflo(w.x), a1 = bfhi(w.x), a2 = bflo(w.y), a3 = bfhi(w.y), a4 = bflo(w.z), a5 = bfhi(w.z), a6 = bflo(w.w), a7 = bfhi(w.w);
                        float ss = (a0 * a0 + a1 * a1) + (a2 * a2 + a3 * a3) + (a4 * a4 + a5 * a5) + (a6 * a6 + a7 * a7);
                        ss = wave_sum(ss);
                        if (lane == 0) tab[32 * wave + rb + r] = 1.f / sqrtf(ss * (mode == 0 ? 1.f / 512.f : 1.f / 256.f) + LN_EPS);
                    }
                }
                __syncthreads();
                pg8::Gemm g;
                if (mode == 0) g = pg8::Gemm{P + COL_CQ, (const bf16_t*)(ws + WS_WUQ), NIN, 512, 512};
                else if (mode == 1) g = pg8::Gemm{P + COL_CKV, (const bf16_t*)(ws + WS_WK), NIN, 256, 256};
                else g = pg8::Gemm{(const bf16_t*)(ws + WS_WV), P + COL_CKV, 256, NIN, 256};
                pg8::SingleUnit S; S.u0.pm = pm; S.u0.pn = pn;
                pg8::EpiLR E{mode, mode == 0 ? QA : (mode == 1 ? KN : VT), mode == 0 ? 1536 : (mode == 1 ? 1024 : M), tab, ROPE};
                pg8::gemm_phase<pg8::EpiLR, pg8::SingleUnit, false>(lds, g, S, E);
            }
            __syncthreads();
            for (int rs_ = 0; rs_ < ((DBG_REP_SUB == 4) ? 2 : 1); ++rs_)
            {
                const float* conv_w = args.in[10]; const float* conv_b = args.in[11];
                {
                    const int cgp = tid & 127, ch0 = 8 * cgp;
                    float cwr[5][8];
#pragma unroll
                    for (int j = 0; j < 4; ++j)
#pragma unroll
                        for (int i = 0; i < 8; ++i) cwr[j][i] = conv_w[j * 1024 + ch0 + i];
#pragma unroll
                    for (int i = 0; i < 8; ++i) cwr[4][i] = conv_b[ch0 + i];
                    const float ksc = (ch0 < 512) ? 1.0f : 0.08838834764831845f;
                    bf16_t* dstb = (ch0 < 512) ? QC + ch0 : KC + (ch0 - 512);
                    for (int row = bid * 4 + (tid >> 7); row < M; row += G * 4) {
                        const int sq = row & (SEQ - 1);
                        u32x4 xr[4];
#pragma unroll
                        for (int r = 0; r < 4; ++r) xr[r] = (sq - 3 + r >= 0) ? *(const u32x4*)(P + (size_t)(row - 3 + r) * NIN + ch0) : (u32x4){0u, 0u, 0u, 0u};
                        unsigned ow[4];
#pragma unroll
                        for (int wd = 0; wd < 4; ++wd) {
                            float a0 = cwr[4][2 * wd], a1 = cwr[4][2 * wd + 1];
#pragma unroll
                            for (int r = 0; r < 4; ++r) { const unsigned w = (wd == 0) ? xr[r].x : (wd == 1) ? xr[r].y : (wd == 2) ? xr[r].z : xr[r].w; a0 += cwr[r][2 * wd] * bflo(w); a1 += cwr[r][2 * wd + 1] * bfhi(w); }
                            ow[wd] = cvt_pk_bf16(silu_f(a0) * ksc, silu_f(a1) * ksc);
                        }
                        *(u32x4*)(dstb + (size_t)row * 512) = (u32x4){ow[0], ow[1], ow[2], ow[3]};
                    }
                }
                LAS unsigned char* tl = lds + wave * 9216;
                for (int tix = gw; tix < 128 * 16; tix += NGW) {
                    const int tt = tix >> 4, et = tix & 15;
#pragma unroll
                    for (int c = 0; c < 8; ++c) {
                        const u32x4 v = *(const u32x4*)(P + (size_t)(tt * 64 + lane) * NIN + 1024 + et * 64 + 8 * c);
                        const unsigned wv[4] = {v.x, v.y, v.z, v.w};
#pragma unroll
                        for (int i = 0; i < 4; ++i) { *(LAS bf16_t*)(tl + (8 * c + 2 * i) * 144 + 2 * lane) = (bf16_t)(wv[i] & 0xffffu); *(LAS bf16_t*)(tl + (8 * c + 2 * i + 1) * 144 + 2 * lane) = (bf16_t)(wv[i] >> 16); }
                    }
                    LDS_WAIT(); asm volatile("" ::: "memory");
#pragma unroll
                    for (int c = 0; c < 8; ++c) { const u32x4 v = *(const LAS u32x4*)(tl + lane * 144 + 16 * c); *(u32x4*)(VTM + (size_t)(et * 64 + lane) * M + tt * 64 + 8 * c) = v; }
                    LDS_WAIT(); asm volatile("" ::: "memory");
                }
                if (gw < 16) {
                    const int b = gw >> 2, h = gw & 3; const float big = args.in[12][h], bfg = args.in[13][h];
                    const float* gp = GATES + (size_t)(b * SEQ + 32 * lane) * 8;
                    float ev[32], cv[32];
#pragma unroll
                    for (int i = 0; i < 32; ++i) { ev[i] = gp[i * 8 + h] + big; const float fp = gp[i * 8 + 4 + h] + bfg; cv[i] = fminf(fp, 0.f) - log1pf(__expf(-fabsf(fp))); }
#pragma unroll
                    for (int i = 1; i < 32; ++i) cv[i] += cv[i - 1];
                    float tot = cv[31], inc = tot;
#pragma unroll
                    for (int d = 1; d < 64; d <<= 1) { const float t = __shfl_up(inc, d); if (lane >= d) inc += t; }
                    const float off = inc - tot;
#pragma unroll
                    for (int i = 0; i < 32; ++i) ev[i] = (ev[i] - (cv[i] + off)) * 1.4426950408889634f;
#pragma unroll
                    for (int i = 0; i < 32; ++i) cv[i] = (i == 0) ? ev[0] : fmaxf(cv[i - 1], ev[i]);
                    float mx = cv[31];
#pragma unroll
                    for (int d = 1; d < 64; d <<= 1) { const float t = __shfl_up(mx, d); if (lane >= d) mx = fmaxf(mx, t); }
                    float mo = __shfl_up(mx, 1); if (lane == 0) mo = -1e30f;
                    float* eo = EG + gw * SEQ + 32 * lane; float* mo_ = MG + gw * SEQ + 32 * lane;
#pragma unroll
                    for (int i = 0; i < 32; i += 4) {
                        *(f32x4*)(eo + i) = (f32x4){ev[i], ev[i + 1], ev[i + 2], ev[i + 3]};
                        *(f32x4*)(mo_ + i) = (f32x4){fmaxf(cv[i], mo), fmaxf(cv[i + 1], mo), fmaxf(cv[i + 2], mo), fmaxf(cv[i + 3], mo)};
                    }
                }
            }
    }
    GRID_SYNC();
    for (int rep_ = 0; rep_ < ((7 == DBG_REP_PH) ? 2 : 1); ++rep_) { constexpr int ph = 7; PH_THREAD(); if (rep_) { asm volatile("s_waitcnt vmcnt(0)" ::: "memory"); __syncthreads(); }
#if !DBG_NO_MLSTM
            for (int it = bid; it < 128; it += G) {
                const int bh = it >> 3, eh = (it >> 2) & 1, pr = it & 3;
                mlp_unit(QC, KC, VTM, EG, MG, HRAW, bh >> 2, bh & 3, 7 - pr, eh, lds, tid, wave, lane);
                mlp_unit(QC, KC, VTM, EG, MG, HRAW, bh >> 2, bh & 3, pr, eh, lds, tid, wave, lane);
#if DBG_MIX2 & 1
                mlp_unit(QC, KC, VTM, EG, MG, HRAW, bh >> 2, bh & 3, 7 - pr, eh, lds, tid, wave, lane);
                mlp_unit(QC, KC, VTM, EG, MG, HRAW, bh >> 2, bh & 3, pr, eh, lds, tid, wave, lane);
#endif
            }
#endif
#if !DBG_NO_ATTN
            for (int it = bid; it < 256; it += G) {
                if (it < 128) continue;
                const int a = it - 128, bh = a >> 2, pr = a & 3;
                attn_unit(QA, KN, P, VT, HM, bh >> 3, bh & 7, 7 - pr, lds, tid, wave, lane);
                attn_unit(QA, KN, P, VT, HM, bh >> 3, bh & 7, pr, lds, tid, wave, lane);
#if DBG_MIX2 & 2
                attn_unit(QA, KN, P, VT, HM, bh >> 3, bh & 7, 7 - pr, lds, tid, wave, lane);
                attn_unit(QA, KN, P, VT, HM, bh >> 3, bh & 7, pr, lds, tid, wave, lane);
#endif
            }
#endif
    }
    GRID_SYNC();
    for (int rep_ = 0; rep_ < ((8 == DBG_REP_PH) ? 2 : 1); ++rep_) { constexpr int ph = 8; PH_THREAD(); if (rep_) { asm volatile("s_waitcnt vmcnt(0)" ::: "memory"); __syncthreads(); }
            const float* mg = args.in[14];
            for (int row = gw; row < M; row += NGW) {
#pragma unroll
                for (int hh = 0; hh < 4; ++hh) {
#if DBG_NO_MLSTM
                    f32x4 v = {0.f, 0.f, 0.f, 0.f};
#else
                    f32x4 v = *((const f32x4*)(HRAW + (size_t)row * 1024 + hh * 256) + lane);
#endif
                    const float mean = wave_sum((v[0] + v[1]) + (v[2] + v[3])) * (1.f / 256.f);
                    v = v - mean;
                    const float rstd = 1.f / sqrtf(wave_sum((v[0] * v[0] + v[1] * v[1]) + (v[2] * v[2] + v[3] * v[3])) * (1.f / 256.f) + LN_EPS);
                    const f32x4 gg = *((const f32x4*)(mg + hh * 256) + lane);
                    const u32x2 ow = *((const u32x2*)(P + (size_t)row * NIN + 2048 + hh * 256) + lane);
                    const float o0 = bflo(ow.x), o1 = bfhi(ow.x), o2 = bflo(ow.y), o3 = bfhi(ow.y);
                    f32x4 y = v * rstd * gg;
                    y[0] *= 1.f / (1.f + __expf(-o0)); y[1] *= 1.f / (1.f + __expf(-o1)); y[2] *= 1.f / (1.f + __expf(-o2)); y[3] *= 1.f / (1.f + __expf(-o3));
                    u32x2 w; w.x = cvt_pk_bf16(y[0], y[1]); w.y = cvt_pk_bf16(y[2], y[3]);
                    *((u32x2*)(HM + (size_t)row * D + hh * 256) + lane) = w;
#if DBG_NO_ATTN
                    *((u32x2*)(HM + (size_t)row * D + 1024 + hh * 256) + lane) = (u32x2){0u, 0u};
#endif
                }
            }
            }
    GRID_SYNC();
    for (int rep_ = 0; rep_ < ((9 == DBG_REP_PH) ? 2 : 1); ++rep_) { constexpr int ph = 9; PH_THREAD(); if (rep_) { asm volatile("s_waitcnt vmcnt(0)" ::: "memory"); __syncthreads(); }
            const int s = (ph == 3) ? 0 : (ph == 9 ? 1 : 2);
            const bf16_t* A = (ph == 9) ? HM : Hb; const bf16_t* Wt = (const bf16_t*)(ws + (ph == 3 ? WS_W2A : (ph == 9 ? WS_WOUT : WS_W2B)));
            const int K = (ph == 9) ? D : FF;
            const float* Xr = (ph == 3) ? x_in : X;
            pg8::Gemm g{A, Wt, K, K, K}; pg8::StaticOrder S; S.init(M, D, G, bid);
            pg8::EpiResid E{Xr, Z, MOD + s * 6144 + 4096, (ph == 9) ? 1.0f : 0.5f};
            pg8::gemm_phase<pg8::EpiResid, pg8::StaticOrder, true>(lds, g, S, E);
            }
    GRID_SYNC();
    for (int rep_ = 0; rep_ < ((10 == DBG_REP_PH) ? 2 : 1); ++rep_) { constexpr int ph = 10; PH_THREAD(); if (rep_) { asm volatile("s_waitcnt vmcnt(0)" ::: "memory"); __syncthreads(); }
            const int s = (ph == 4) ? 1 : 2;
            const float* gp = args.in[ph == 4 ? 7 : (ph == 10 ? 20 : 25)]; const float* bp = args.in[ph == 4 ? 8 : (ph == 10 ? 21 : 26)];
            float* Xo = (ph == 13) ? args.out : X;
            for (int row = gw; row < M; row += NGW) {
                const int b = row >> 11; const float* mb = MOD + (size_t)b * NMOD + s * 6144;
                const f32x4* zr = (const f32x4*)(Z + (size_t)row * D) + lane;
                f32x4 v[8]; float sm = 0.f;
#pragma unroll
                for (int j = 0; j < 8; ++j) { v[j] = zr[64 * j]; sm += (v[j][0] + v[j][1]) + (v[j][2] + v[j][3]); }
                const float mean = wave_sum(sm) * (1.f / D); float s2 = 0.f;
#pragma unroll
                for (int j = 0; j < 8; ++j) { v[j] = v[j] - mean; s2 += (v[j][0] * v[j][0] + v[j][1] * v[j][1]) + (v[j][2] * v[j][2] + v[j][3] * v[j][3]); }
                const float rstd = 1.f / sqrtf(wave_sum(s2) * (1.f / D) + LN_EPS);
                f32x4* xo = (f32x4*)(Xo + (size_t)row * D) + lane; u32x2* ur = (u32x2*)(U + (size_t)row * D) + lane;
#pragma unroll
                for (int j = 0; j < 8; ++j) {
                    const f32x4 gg = *((const f32x4*)gp + lane + 64 * j), bb = *((const f32x4*)bp + lane + 64 * j);
                    const f32x4 y = v[j] * rstd * gg + bb; xo[64 * j] = y;
                    if (ph != 13) { const f32x4 sh = *((const f32x4*)mb + lane + 64 * j), scl = *((const f32x4*)(mb + 2048) + lane + 64 * j);
                        const f32x4 uu = y * (scl + 1.0f) + sh; u32x2 w; w.x = cvt_pk_bf16(uu[0], uu[1]); w.y = cvt_pk_bf16(uu[2], uu[3]); ur[64 * j] = w; }
                }
            }
            }
    GRID_SYNC();
    for (int rep_ = 0; rep_ < ((11 == DBG_REP_PH) ? 2 : 1); ++rep_) { constexpr int ph = 11; PH_THREAD(); if (rep_) { asm volatile("s_waitcnt vmcnt(0)" ::: "memory"); __syncthreads(); }
            const bf16_t* Wt = (const bf16_t*)(ws + (ph == 2 ? WS_W13A : WS_W13B));
            pg8::Gemm g{U, Wt, D, D, D}; pg8::StaticOrder S; S.init(M, 2 * FF, G, bid);
            pg8::EpiSwiglu E{Hb};
            pg8::gemm_phase<pg8::EpiSwiglu, pg8::StaticOrder, true>(lds, g, S, E);
            if (ph == 2 && G == 256 && bid >= 128) {
                constexpr int I_UP = 32 * 88, I_DN = 88 * 32;
                __syncthreads();
                LAS float* scr = (LAS float*)(lds + wave * TR_BYTES);
                for (int it = (bid - 128) * 8 + wave; it < I_UP + I_DN; it += 1024) {
                    int r = it;
                    if (r < I_UP) { tr_item(args.in[23], D, FF, (bf16_t*)(ws + WS_W13B), 1, nullptr, scr, r, lane); continue; } r -= I_UP;
                    tr_item(args.in[24], FF, D, (bf16_t*)(ws + WS_W2B), 2, nullptr, scr, r, lane);
                }
            }
            }
    GRID_SYNC();
    for (int rep_ = 0; rep_ < ((12 == DBG_REP_PH) ? 2 : 1); ++rep_) { constexpr int ph = 12; PH_THREAD(); if (rep_) { asm volatile("s_waitcnt vmcnt(0)" ::: "memory"); __syncthreads(); }
            const int s = (ph == 3) ? 0 : (ph == 9 ? 1 : 2);
            const bf16_t* A = (ph == 9) ? HM : Hb; const bf16_t* Wt = (const bf16_t*)(ws + (ph == 3 ? WS_W2A : (ph == 9 ? WS_WOUT : WS_W2B)));
            const int K = (ph == 9) ? D : FF;
            const float* Xr = (ph == 3) ? x_in : X;
            pg8::Gemm g{A, Wt, K, K, K}; pg8::StaticOrder S; S.init(M, D, G, bid);
            pg8::EpiResid E{Xr, Z, MOD + s * 6144 + 4096, (ph == 9) ? 1.0f : 0.5f};
            pg8::gemm_phase<pg8::EpiResid, pg8::StaticOrder, true>(lds, g, S, E);
            }
    GRID_SYNC();
    for (int rep_ = 0; rep_ < ((13 == DBG_REP_PH) ? 2 : 1); ++rep_) { constexpr int ph = 13; PH_THREAD(); if (rep_) { asm volatile("s_waitcnt vmcnt(0)" ::: "memory"); __syncthreads(); }
            const int s = (ph == 4) ? 1 : 2;
            const float* gp = args.in[ph == 4 ? 7 : (ph == 10 ? 20 : 25)]; const float* bp = args.in[ph == 4 ? 8 : (ph == 10 ? 21 : 26)];
            float* Xo = (ph == 13) ? args.out : X;
            for (int row = gw; row < M; row += NGW) {
                const int b = row >> 11; const float* mb = MOD + (size_t)b * NMOD + s * 6144;
                const f32x4* zr = (const f32x4*)(Z + (size_t)row * D) + lane;
                f32x4 v[8]; float sm = 0.f;
#pragma unroll
                for (int j = 0; j < 8; ++j) { v[j] = zr[64 * j]; sm += (v[j][0] + v[j][1]) + (v[j][2] + v[j][3]); }
                const float mean = wave_sum(sm) * (1.f / D); float s2 = 0.f;
#pragma unroll
                for (int j = 0; j < 8; ++j) { v[j] = v[j] - mean; s2 += (v[j][0] * v[j][0] + v[j][1] * v[j][1]) + (v[j][2] * v[j][2] + v[j][3] * v[j][3]); }
                const float rstd = 1.f / sqrtf(wave_sum(s2) * (1.f / D) + LN_EPS);
                f32x4* xo = (f32x4*)(Xo + (size_t)row * D) + lane; u32x2* ur = (u32x2*)(U + (size_t)row * D) + lane;
#pragma unroll
                for (int j = 0; j < 8; ++j) {
                    const f32x4 gg = *((const f32x4*)gp + lane + 64 * j), bb = *((const f32x4*)bp + lane + 64 * j);
                    const f32x4 y = v[j] * rstd * gg + bb; xo[64 * j] = y;
                    if (ph != 13) { const f32x4 sh = *((const f32x4*)mb + lane + 64 * j), scl = *((const f32x4*)(mb + 2048) + lane + 64 * j);
                        const f32x4 uu = y * (scl + 1.0f) + sh; u32x2 w; w.x = cvt_pk_bf16(uu[0], uu[1]); w.y = cvt_pk_bf16(uu[2], uu[3]); ur[64 * j] = w; }
                }
            }
            }
}

extern "C" void kernel_launch(void* const* d_in, const int* in_sizes, int n_in, void* d_out, int out_size, void* d_ws, size_t ws_size, hipStream_t stream) {
    static int grid = 0;
    if (grid == 0) {
        if (n_in != 27 || out_size != M * D || ws_size < WS_END) { fprintf(stderr, "kernel_launch: unexpected shapes (n_in %d out %d ws %zu need %zu)\n", n_in, out_size, ws_size, (size_t)WS_END); grid = -1; return; }
        int dev = 0, cus = 0, per_cu = 0;
        hipGetDevice(&dev); hipDeviceGetAttribute(&cus, hipDeviceAttributeMultiprocessorCount, dev);
        if (hipFuncSetAttribute((const void*)fwd_kernel, hipFuncAttributeMaxDynamicSharedMemorySize, LDS_BYTES) != hipSuccess) { fprintf(stderr, "kernel_launch: hipFuncSetAttribute failed\n"); grid = -1; return; }
        hipOccupancyMaxActiveBlocksPerMultiprocessor(&per_cu, (const void*)fwd_kernel, 512, LDS_BYTES);
        (void)hipGetLastError();
        if (per_cu < 1) { fprintf(stderr, "kernel_launch: occupancy query says %d blocks/CU\n", per_cu); per_cu = 1; }
        grid = cus;
    }
    if (grid < 0) return;
    if (hipMemsetAsync(d_ws, 0, 16384, stream) != hipSuccess) { fprintf(stderr, "kernel_launch: memset of barrier words failed\n"); return; }
    Args a{};
    for (int i = 0; i < 27; ++i) a.in[i] = (const float*)d_in[i];
    a.out = (float*)d_out; a.ws = (unsigned char*)d_ws;
    void* kargs[] = {&a};
    hipError_t e = hipLaunchCooperativeKernel((const void*)fwd_kernel, dim3(grid), dim3(512), kargs, LDS_BYTES, stream);
    if (e != hipSuccess) fprintf(stderr, "kernel_launch: cooperative launch failed: %s (grid %d)\n", hipGetErrorString(e), grid);
}
```
